# Optimizing an MI355X kernel written in HIP

```python
import math
import jax
import jax.numpy as jnp
from jax import lax
import numpy as np

D_MODEL = 2048
BATCH = 16
SEQ = 256
DEPTH = 4
DEC_BATCH = 4
DEC_SEQ = 1024
PAST_LEN = 256

GRID_W = 64
N_MIXERS = 4
Q_BLOCK = 128
EPS = 1e-6
ROPE_BASE = 10000.0
NEG = -1e30

N_A = (DEPTH + 3) // N_MIXERS
N_B = (DEPTH + 2) // N_MIXERS
N_C = (DEPTH + 1) // N_MIXERS
N_D = DEPTH // N_MIXERS

A_HEADS = 16
A_DH = 64
B_HEADS = 16
B_DK = 128
B_DV = D_MODEL // B_HEADS
B_CHUNK = 32
C_HEADS = 16
C_NOPE = 128
C_ROPE = 64
C_VD = 128
C_QLORA = 512
C_KVLORA = 256
D_HEADS = 32
D_KV_HEADS = 4
D_DH = 64
D_WINDOW = 128
D_FF = -(-8 * D_MODEL // (3 * 256)) * 256

kernel_name = 'hybrid_diffusion_prefix_trunk_step'


def rms_norm(x, g):
    xf = x.astype(jnp.float32)
    y = xf * lax.rsqrt(jnp.mean(xf * xf, axis=-1, keepdims=True) + EPS)
    return (y * g.astype(jnp.float32)).astype(x.dtype)


def modulate(h, shift, scale):
    return h * (1 + scale) + shift


def grid_positions(n_tok):
    rows = n_tok // GRID_W
    row = jnp.repeat(jnp.arange(rows), GRID_W)
    col = jnp.tile(jnp.arange(GRID_W), rows)
    return row, col


def rope_2d(x):
    n_tok, d = x.shape[1], x.shape[-1]
    row, col = grid_positions(n_tok)
    half = d // 2
    nf = half // 2
    inv_freq = ROPE_BASE ** (-jnp.arange(nf, dtype=jnp.float32) / nf)
    bshape = (n_tok,) + (1,) * (x.ndim - 3) + (nf,)

    def rot(xa, pos):
        ang = (pos.astype(jnp.float32)[:, None] * inv_freq[None, :]).reshape(bshape)
        cos, sin = jnp.cos(ang), jnp.sin(ang)
        x1 = xa[..., :nf].astype(jnp.float32)
        x2 = xa[..., nf:].astype(jnp.float32)
        return jnp.concatenate([x1 * cos - x2 * sin, x2 * cos + x1 * sin], axis=-1)

    y = jnp.concatenate([rot(x[..., :half], row), rot(x[..., half:], col)], axis=-1)
    return y.astype(x.dtype)


def map_query_blocks(body, q):
    b, s = q.shape[:2]
    nb = s // Q_BLOCK
    qb = jnp.moveaxis(q.reshape((b, nb, Q_BLOCK) + q.shape[2:]), 1, 0)
    out = lax.map(body, (qb, jnp.arange(nb)))
    return jnp.moveaxis(out, 0, 1).reshape((b, s) + out.shape[3:])


def softmax_with_sink(s, sink):
    m = jnp.maximum(jnp.max(s, axis=-1, keepdims=True), sink)
    e = jnp.exp(s - m)
    return e / (jnp.sum(e, axis=-1, keepdims=True) + jnp.exp(sink - m))


def gqa_core(q, k, v, sink=None):
    h, dh = q.shape[2], q.shape[3]
    g = k.shape[2]
    r = h // g
    scale = dh ** -0.5

    def body(args):
        qb, _ = args
        b, nq = qb.shape[:2]
        qg = qb.reshape(b, nq, g, r, dh)
        s = jnp.einsum('bqgrd,bkgd->bgrqk', qg, k).astype(jnp.float32) * scale
        if sink is None:
            p = jax.nn.softmax(s, axis=-1)
        else:
            p = softmax_with_sink(s, sink.astype(jnp.float32).reshape(g, r, 1, 1))
        o = jnp.einsum('bgrqk,bkge->bqgre', p.astype(v.dtype), v)
        return o.reshape(b, nq, h, o.shape[-1])

    return map_query_blocks(body, q)


def diff_lambda(lam_p, layer_idx):
    lam_init = 0.8 - 0.6 * math.exp(-0.3 * layer_idx)
    lp = lam_p.astype(jnp.float32)
    lam = jnp.exp(jnp.sum(lp[0] * lp[1])) - jnp.exp(jnp.sum(lp[2] * lp[3])) + lam_init
    return lam, lam_init


def diff_attn_project(h, wq, wk, wv):
    b, t, _ = h.shape
    q = (h @ wq).reshape(b, t, A_HEADS, 2, A_DH)
    k = (h @ wk).reshape(b, t, A_HEADS, 2, A_DH)
    v = (h @ wv).reshape(b, t, A_HEADS, 2 * A_DH)
    return q, k, v


def diff_attn_core(q, k, v, lam):
    scale = A_DH ** -0.5

    def body(args):
        qb, _ = args
        s = jnp.einsum('bqhcd,bkhcd->bhcqk', qb, k).astype(jnp.float32) * scale
        pr = jax.nn.softmax(s, axis=-1)
        w = pr[:, :, 0] - lam * pr[:, :, 1]
        return jnp.einsum('bhqk,bkhe->bqhe', w.astype(v.dtype), v)

    return map_query_blocks(body, q)


def diff_attn_output(o, subln, lam_init, wo):
    o = rms_norm(o, subln) * (1.0 - lam_init)
    return o.reshape(o.shape[:2] + (-1,)) @ wo


def diff_attn_context(h, wq, wk, wv, wo, lam_p, subln, layer_idx):
    b, t, _ = h.shape
    q, k, v = diff_attn_project(h, wq, wk, wv)
    lam, lam_init = diff_lambda(lam_p, layer_idx)
    y = diff_attn_output(diff_attn_core(q, k, v, lam), subln, lam_init, wo)
    return y, k.reshape(b, t, A_HEADS, 2 * A_DH), v


def diff_attn_latent(h, k_ctx, v_ctx, wq, wk, wv, wo, lam_p, subln, layer_idx):
    q, k, v = diff_attn_project(h, wq, wk, wv)
    q, k = rope_2d(q), rope_2d(k)
    b, n = k_ctx.shape[:2]
    k_all = jnp.concatenate([k_ctx.reshape(b, n, A_HEADS, 2, A_DH), k], axis=1)
    v_all = jnp.concatenate([v_ctx, v], axis=1)
    lam, lam_init = diff_lambda(lam_p, layer_idx)
    return diff_attn_output(diff_attn_core(q, k_all, v_all, lam), subln, lam_init, wo)


def hgrn2_lower_bound(lower, layer_idx):
    p = jax.nn.softmax(lower.astype(jnp.float32), axis=0)
    return (jnp.cumsum(p, axis=0) - p[0])[layer_idx]


def gla_chunked(q, k, v, logf, s0):
    b, t, h, _ = q.shape
    n = t // B_CHUNK

    def chunks(a):
        return jnp.moveaxis(a.reshape((b, n, B_CHUNK) + a.shape[2:]), 1, 0).astype(jnp.float32)

    qc, kc, vc, gc = chunks(q), chunks(k), chunks(v), chunks(logf)
    causal = jnp.tril(jnp.ones((B_CHUNK, B_CHUNK), dtype=bool))

    def step(s, inp):
        qi, ki, vi, gi = inp
        bcum = jnp.cumsum(gi, axis=1)
        q_dec = qi * jnp.exp(bcum)
        k_inv = ki * jnp.exp(-bcum)
        a = jnp.where(causal, jnp.einsum('bthd,bshd->bhts', q_dec, k_inv), 0.0)
        o = jnp.einsum('bhts,bshv->bthv', a, vi) + jnp.einsum('bthd,bhdv->bthv', q_dec, s)
        b_last = bcum[:, -1]
        k_end = ki * jnp.exp(b_last[:, None] - bcum)
        s_new = jnp.exp(b_last)[..., None] * s + jnp.einsum('bshd,bshv->bhdv', k_end, vi)
        return s_new, o

    s_fin, o = lax.scan(step, s0.astype(jnp.float32), (qc, kc, vc, gc))
    o = jnp.moveaxis(o, 0, 1).reshape(b, t, h, -1)
    return o, s_fin


def hgrn2_mixer(h, s0_fwd, s0_bwd, wq, wi, wf, wg, gnorm, wo, lb):
    b, t, _ = h.shape
    q = jax.nn.silu(h @ wq).reshape(b, t, B_HEADS, B_DK)
    inp = (h @ wi).reshape(b, t, B_HEADS, B_DV)
    outs, states = [], []
    for d, s0 in enumerate((s0_fwd, s0_bwd)):
        z = (h @ wf[d]).astype(jnp.float32)
        f = lb[d] + (1.0 - lb[d]) * jax.nn.sigmoid(z)
        logf = jnp.log(f).reshape(b, t, B_HEADS, B_DK)
        kk = (1.0 - f).reshape(b, t, B_HEADS, B_DK)
        qd, vd = q, inp
        if d == 1:
            qd, kk, vd, logf = (jnp.flip(a, axis=1) for a in (qd, kk, vd, logf))
        o, s = gla_chunked(qd, kk, vd, logf, s0)
        if d == 1:
            o = jnp.flip(o, axis=1)
        outs.append(o)
        states.append(s.astype(h.dtype))
    g = (h @ wg).reshape(b, t, B_HEADS, B_DV).astype(jnp.float32)
    o = rms_norm(outs[0] + outs[1], gnorm) * jax.nn.silu(g)
    y = o.reshape(b, t, B_HEADS * B_DV).astype(h.dtype) @ wo
    return y, states[0], states[1]


def mla_queries(h, wdq, qnorm, wuq):
    b, t, _ = h.shape
    q = (rms_norm(h @ wdq, qnorm) @ wuq).reshape(b, t, C_HEADS, C_NOPE + C_ROPE)
    return q[..., :C_NOPE], q[..., C_NOPE:]


def mla_compress(h, wdkv, kvnorm):
    ckv = h @ wdkv
    return rms_norm(ckv[..., :C_KVLORA], kvnorm), ckv[..., C_KVLORA:]


def mla_expand(ckv, kpe, wuk, wuv):
    b, n, _ = ckv.shape
    k_nope = (ckv @ wuk).reshape(b, n, C_HEADS, C_NOPE)
    v = (ckv @ wuv).reshape(b, n, C_HEADS, C_VD)
    k_pe = jnp.broadcast_to(kpe[:, :, None, :], (b, n, C_HEADS, C_ROPE))
    return jnp.concatenate([k_nope, k_pe], axis=-1), v


def mla_out(o, wo):
    return o.reshape(o.shape[:2] + (-1,)) @ wo


def mla_context(h, wdq, qnorm, wuq, wdkv, kvnorm, wuk, wuv, wo):
    q_nope, q_pe = mla_queries(h, wdq, qnorm, wuq)
    ckv, kpe = mla_compress(h, wdkv, kvnorm)
    k, v = mla_expand(ckv, kpe, wuk, wuv)
    o = gqa_core(jnp.concatenate([q_nope, q_pe], axis=-1), k, v)
    return mla_out(o, wo), ckv, kpe


def mla_latent(h, ckv_ctx, kpe_ctx, wdq, qnorm, wuq, wdkv, kvnorm, wuk, wuv, wo):
    q_nope, q_pe = mla_queries(h, wdq, qnorm, wuq)
    ckv, kpe = mla_compress(h, wdkv, kvnorm)
    q = jnp.concatenate([q_nope, rope_2d(q_pe)], axis=-1)
    ckv_all = jnp.concatenate([ckv_ctx, ckv], axis=1)
    kpe_all = jnp.concatenate([kpe_ctx, rope_2d(kpe)], axis=1)
    k, v = mla_expand(ckv_all, kpe_all, wuk, wuv)
    return mla_out(gqa_core(q, k, v), wo)


def swa_project(h, wq, wk, wv):
    b, t, _ = h.shape
    q = (h @ wq).reshape(b, t, D_HEADS, D_DH)
    k = (h @ wk).reshape(b, t, D_KV_HEADS, D_DH)
    v = (h @ wv).reshape(b, t, D_KV_HEADS, D_DH)
    return q, k, v


def swa_latent_attention(q, k, v, k_ctx, v_ctx, sink):
    b, t, h, dh = q.shape
    g = k.shape[2]
    r = h // g
    band = Q_BLOCK + 2 * D_WINDOW
    pad = ((0, 0), (D_WINDOW, D_WINDOW), (0, 0), (0, 0))
    k_pad = jnp.pad(k, pad)
    v_pad = jnp.pad(v, pad)
    sink_b = sink.astype(jnp.float32).reshape(g, r, 1, 1)
    scale = dh ** -0.5

    def body(args):
        qb, n = args
        start = n * Q_BLOCK
        kb = lax.dynamic_slice_in_dim(k_pad, start, band, axis=1)
        vb = lax.dynamic_slice_in_dim(v_pad, start, band, axis=1)
        qpos = start + jnp.arange(Q_BLOCK)
        kpos = start - D_WINDOW + jnp.arange(band)
        valid = ((jnp.abs(qpos[:, None] - kpos[None, :]) <= D_WINDOW)
                 & (kpos >= 0)[None, :] & (kpos < t)[None, :])
        qg = qb.reshape(b, Q_BLOCK, g, r, dh)
        s_ctx = jnp.einsum('bqgrd,bkgd->bgrqk', qg, k_ctx).astype(jnp.float32)
        s_lat = jnp.einsum('bqgrd,bkgd->bgrqk', qg, kb).astype(jnp.float32)
        s_lat = jnp.where(valid, s_lat, NEG)
        s = jnp.concatenate([s_ctx, s_lat], axis=-1) * scale
        p = softmax_with_sink(s, sink_b)
        vals = jnp.concatenate([v_ctx, vb], axis=1)
        o = jnp.einsum('bgrqk,bkge->bqgre', p.astype(v.dtype), vals)
        return o.reshape(b, Q_BLOCK, h, dh)

    return map_query_blocks(body, q)


def swa_context(h, wq, wk, wv, sink, wo):
    q, k, v = swa_project(h, wq, wk, wv)
    o = gqa_core(q, k, v, sink)
    return o.reshape(o.shape[:2] + (-1,)) @ wo, k, v


def swa_latent(h, k_ctx, v_ctx, wq, wk, wv, sink, wo):
    q, k, v = swa_project(h, wq, wk, wv)
    o = swa_latent_attention(rope_2d(q), rope_2d(k), v, k_ctx, v_ctx, sink)
    return o.reshape(o.shape[:2] + (-1,)) @ wo


def swiglu(h, wg, wu, wd):
    return (jax.nn.silu(h @ wg) * (h @ wu)) @ wd


def setup_inputs(seed: int = 0) -> dict:
    key = jax.random.key(seed)
    ks = iter(jax.random.split(key, 64))
    D = D_MODEL

    def nrm(shape, scale=1.0):
        return jax.random.normal(next(ks), shape, jnp.float32) * scale

    def lin(shape, mult=1.0):
        return nrm(shape, mult * shape[-2] ** -0.5)

    def gain(shape):
        return 1.0 + nrm(shape, 0.1)

    return {
        'x_prompt': nrm((BATCH, SEQ, D)),
        'x_sample': nrm((DEC_BATCH, DEC_SEQ, D)),
        'cache_a_k': nrm((DEC_BATCH, N_A, PAST_LEN, A_HEADS, 2 * A_DH)),
        'cache_a_v': nrm((DEC_BATCH, N_A, PAST_LEN, A_HEADS, 2 * A_DH)),
        'state_b_fwd': nrm((DEC_BATCH, N_B, B_HEADS, B_DK, B_DV), 0.5),
        'state_b_bwd': nrm((DEC_BATCH, N_B, B_HEADS, B_DK, B_DV), 0.5),
        'cache_c_ckv': nrm((DEC_BATCH, N_C, PAST_LEN, C_KVLORA)),
        'cache_c_kpe': nrm((DEC_BATCH, N_C, PAST_LEN, C_ROPE)),
        'cache_d_k': nrm((DEC_BATCH, N_D, PAST_LEN, D_KV_HEADS, D_DH)),
        'cache_d_v': nrm((DEC_BATCH, N_D, PAST_LEN, D_KV_HEADS, D_DH)),
        'c': nrm((DEC_BATCH, D)),
        'c_ctx': nrm((D,)),
        'ada_w': lin((DEPTH, D, 6 * D), 0.5),
        'ada_b': nrm((DEPTH, 6 * D), 0.02),
        'norm_mix_pre': gain((DEPTH, D)),
        'norm_mix_post': gain((DEPTH, D)),
        'norm_ffn_pre': gain((DEPTH, D)),
        'norm_ffn_post': gain((DEPTH, D)),
        'a_wq': lin((N_A, D, A_HEADS * 2 * A_DH)),
        'a_wk': lin((N_A, D, A_HEADS * 2 * A_DH)),
        'a_wv': lin((N_A, D, A_HEADS * 2 * A_DH)),
        'a_wo': lin((N_A, A_HEADS * 2 * A_DH, D)),
        'a_lambda': nrm((N_A, 4, A_DH), 0.1),
        'a_subln': gain((N_A, 2 * A_DH)),
        'b_wq': lin((N_B, D, B_HEADS * B_DK)),
        'b_wi': lin((N_B, D, B_HEADS * B_DV)),
        'b_wf': lin((N_B, 2, D, B_HEADS * B_DK)),
        'b_lower': gain((DEPTH, 2, B_HEADS * B_DK)),
        'b_wg': lin((N_B, D, B_HEADS * B_DV)),
        'b_gnorm': gain((N_B, B_DV)),
        'b_wo': lin((N_B, B_HEADS * B_DV, D)),
        'c_wdq': lin((N_C, D, C_QLORA)),
        'c_qnorm': gain((N_C, C_QLORA)),
        'c_wuq': lin((N_C, C_QLORA, C_HEADS * (C_NOPE + C_ROPE))),
        'c_wdkv': lin((N_C, D, C_KVLORA + C_ROPE)),
        'c_kvnorm': gain((N_C, C_KVLORA)),
        'c_wuk': lin((N_C, C_KVLORA, C_HEADS * C_NOPE)),
        'c_wuv': lin((N_C, C_KVLORA, C_HEADS * C_VD)),
        'c_wo': lin((N_C, C_HEADS * C_VD, D)),
        'd_wq': lin((N_D, D, D_HEADS * D_DH)),
        'd_wk': lin((N_D, D, D_KV_HEADS * D_DH)),
        'd_wv': lin((N_D, D, D_KV_HEADS * D_DH)),
        'd_sink': nrm((N_D, D_HEADS), 0.5),
        'd_wo': lin((N_D, D_HEADS * D_DH, D)),
        'ffn_wg': lin((DEPTH, D, D_FF)),
        'ffn_wu': lin((DEPTH, D, D_FF)),
        'ffn_wd': lin((DEPTH, D_FF, D)),
    }


def reference(x_prompt, x_sample, cache_a_k, cache_a_v, state_b_fwd, state_b_bwd,
              cache_c_ckv, cache_c_kpe, cache_d_k, cache_d_v, c, c_ctx,
              ada_w, ada_b, norm_mix_pre, norm_mix_post, norm_ffn_pre, norm_ffn_post,
              a_wq, a_wk, a_wv, a_wo, a_lambda, a_subln,
              b_wq, b_wi, b_wf, b_lower, b_wg, b_gnorm, b_wo,
              c_wdq, c_qnorm, c_wuq, c_wdkv, c_kvnorm, c_wuk, c_wuv, c_wo,
              d_wq, d_wk, d_wv, d_sink, d_wo,
              ffn_wg, ffn_wu, ffn_wd):
    ctx = x_prompt
    lat = x_sample
    new_a_k, new_a_v = [], []
    new_b_fwd, new_b_bwd = [], []
    new_c_ckv, new_c_kpe = [], []
    new_d_k, new_d_v = [], []
    for i in range(DEPTH):
        m, j = i % N_MIXERS, i // N_MIXERS
        mod_c = jnp.split(jax.nn.silu(c_ctx) @ ada_w[i] + ada_b[i], 6, axis=-1)
        mod_l = [u[:, None, :] for u in jnp.split(jax.nn.silu(c) @ ada_w[i] + ada_b[i], 6, axis=-1)]

        hc = modulate(rms_norm(ctx, norm_mix_pre[i]), mod_c[0], mod_c[1])
        hl = modulate(rms_norm(lat, norm_mix_pre[i]), mod_l[0], mod_l[1])
        if m == 0:
            oc, kc, vc = diff_attn_context(hc, a_wq[j], a_wk[j], a_wv[j], a_wo[j], a_lambda[j], a_subln[j], i)
            ol = diff_attn_latent(hl, cache_a_k[:, j], cache_a_v[:, j], a_wq[j], a_wk[j], a_wv[j],
                                  a_wo[j], a_lambda[j], a_subln[j], i)
            new_a_k.append(kc)
            new_a_v.append(vc)
        elif m == 1:
            lb = hgrn2_lower_bound(b_lower, i)
            zeros = jnp.zeros((ctx.shape[0], B_HEADS, B_DK, B_DV), ctx.dtype)
            oc, sf, sb = hgrn2_mixer(hc, zeros, zeros, b_wq[j], b_wi[j], b_wf[j], b_wg[j],
                                     b_gnorm[j], b_wo[j], lb)
            ol, _, _ = hgrn2_mixer(hl, state_b_fwd[:, j], state_b_bwd[:, j], b_wq[j], b_wi[j], b_wf[j],
                                   b_wg[j], b_gnorm[j], b_wo[j], lb)
            new_b_fwd.append(sf)
            new_b_bwd.append(sb)
        elif m == 2:
            oc, ckv, kpe = mla_context(hc, c_wdq[j], c_qnorm[j], c_wuq[j], c_wdkv[j], c_kvnorm[j],
                                       c_wuk[j], c_wuv[j], c_wo[j])
            ol = mla_latent(hl, cache_c_ckv[:, j], cache_c_kpe[:, j], c_wdq[j], c_qnorm[j], c_wuq[j],
                            c_wdkv[j], c_kvnorm[j], c_wuk[j], c_wuv[j], c_wo[j])
            new_c_ckv.append(ckv)
            new_c_kpe.append(kpe)
        else:
            oc, kc, vc = swa_context(hc, d_wq[j], d_wk[j], d_wv[j], d_sink[j], d_wo[j])
            ol = swa_latent(hl, cache_d_k[:, j], cache_d_v[:, j], d_wq[j], d_wk[j], d_wv[j],
                            d_sink[j], d_wo[j])
            new_d_k.append(kc)
            new_d_v.append(vc)
        ctx = ctx + mod_c[2] * rms_norm(oc, norm_mix_post[i])
        lat = lat + mod_l[2] * rms_norm(ol, norm_mix_post[i])

        hc = modulate(rms_norm(ctx, norm_ffn_pre[i]), mod_c[3], mod_c[4])
        hl = modulate(rms_norm(lat, norm_ffn_pre[i]), mod_l[3], mod_l[4])
        ctx = ctx + mod_c[5] * rms_norm(swiglu(hc, ffn_wg[i], ffn_wu[i], ffn_wd[i]), norm_ffn_post[i])
        lat = lat + mod_l[5] * rms_norm(swiglu(hl, ffn_wg[i], ffn_wu[i], ffn_wd[i]), norm_ffn_post[i])

    return (ctx, lat,
            jnp.stack(new_a_k, axis=1), jnp.stack(new_a_v, axis=1),
            jnp.stack(new_b_fwd, axis=1), jnp.stack(new_b_bwd, axis=1),
            jnp.stack(new_c_ckv, axis=1), jnp.stack(new_c_kpe, axis=1),
            jnp.stack(new_d_k, axis=1), jnp.stack(new_d_v, axis=1))
```

```cpp
#include <hip/hip_runtime.h>
#include <cstdio>
#include <cstdint>
namespace pg8 {
#define PG8_LAS __attribute__((address_space(3)))
typedef unsigned short bf16_t;
typedef short bf16x8 __attribute__((ext_vector_type(8)));
typedef float f32x4 __attribute__((ext_vector_type(4)));
typedef unsigned u32x4 __attribute__((ext_vector_type(4)));
constexpr int BM = 256, BK = 64, HALF = 128, HTB = HALF * BK * 2  , STAGE_BYTES = 8 * HTB, NXCD = 8, WGM = 8;

__host__ __device__ __forceinline__ int lds_byte(int r, int c) { const int st = (r >> 4) * 2 + (c >> 5), rr = r & 15, cc = c & 31, ob = rr * 64 + cc * 2; return st * 1024 + (ob ^ (((ob >> 9) & 1) << 5)); }
__host__ __device__ __forceinline__ void stage_rc(int b, int& R, int& C) { const int st = b / 1024, sb = b % 1024, swz = sb ^ (((sb >> 9) & 1) << 5); R = (st >> 1) * 16 + swz / 64; C = (st & 1) * 32 + (swz % 64) / 2; }
__host__ __device__ __forceinline__ int perm32(int rho) { const int n = rho >> 4, i = rho & 15; return 8 * (i >> 2) + 4 * n + (i & 3); }

struct Unit { int pm, pn; };
struct Gemm { const bf16_t* A; const bf16_t* Bt; int M, N, K; };

struct StaticOrder {
    int nM, nN, nwg, G, c;
    __host__ __device__ void init(int M, int N, int G_, int c_) { nM = M / BM; nN = N / BM; nwg = nM * nN; G = G_; c = c_; }
    __host__ __device__ bool next(int i, Unit& u) const {
        const long L = (long)i * G + c; if (L >= nwg) return false;
        int wgid = (int)L; { const int q = nwg / NXCD, r = nwg % NXCD, xcd = wgid % NXCD, off = wgid / NXCD; wgid = (xcd < r ? xcd * (q + 1) : r * (q + 1) + (xcd - r) * q) + off; }
        const int nig = WGM * nN, gid = wgid / nig, fm = gid * WGM, gsz = (nM - fm) < WGM ? (nM - fm) : WGM;
        u.pm = fm + ((wgid % nig) % gsz); u.pn = (wgid % nig) / gsz; return true;
    }
    __device__ __forceinline__ void a_ready(const Unit&) const {}
    __device__ __forceinline__ void done(const Unit&) const {}
};


typedef float f32x2 __attribute__((ext_vector_type(2)));
typedef __bf16 bf16x2_t __attribute__((ext_vector_type(2)));
typedef unsigned u32x2 __attribute__((ext_vector_type(2)));
__device__ __forceinline__ unsigned cvt_pk_bf16(float lo, float hi) { f32x2 v = {lo, hi}; bf16x2_t b = __builtin_convertvector(v, bf16x2_t); return __builtin_bit_cast(unsigned, b); }
__device__ __forceinline__ u32x2 pk4(f32x4 v) { u32x2 w; w.x = cvt_pk_bf16(v[0], v[1]); w.y = cvt_pk_bf16(v[2], v[3]); return w; }
__device__ __forceinline__ u32x4 pk8(f32x4 a, f32x4 b) { u32x4 w; w.x = cvt_pk_bf16(a[0], a[1]); w.y = cvt_pk_bf16(a[2], a[3]); w.z = cvt_pk_bf16(b[0], b[1]); w.w = cvt_pk_bf16(b[2], b[3]); return w; }
__device__ __forceinline__ float fast_exp(float x) { return __builtin_amdgcn_exp2f(x * 1.4426950408889634f); }
__device__ __forceinline__ float sigmoidf_(float x) { return __builtin_amdgcn_rcpf(1.0f + fast_exp(-x)); }
__device__ __forceinline__ float siluf_(float x) { return x * sigmoidf_(x); }
__device__ __forceinline__ f32x4 silu4(f32x4 v) { return (f32x4){siluf_(v[0]), siluf_(v[1]), siluf_(v[2]), siluf_(v[3])}; }

__device__ __forceinline__ int keyrow_of_tile(int pm) { return pm < 16 ? pm * 256 : 4096 + ((pm - 16) >> 2) * 1280 + 256 + ((pm - 16) & 3) * 256; }

struct EpiF32 {
    static constexpr bool PERM = false, AFTER_DRAIN = false;
    float* O; int ldc;
    __device__ __forceinline__ void operator()(const f32x4 (&acc)[2][2][4][2], const Unit& u, int wr, int wc, int fr, int fq) const {
        const int row0 = u.pm * BM + wr * 64 + fr, col0 = u.pn * BM + wc * 32 + 4 * fq;
#pragma unroll
        for (int ai = 0; ai < 2; ++ai)
#pragma unroll
            for (int m = 0; m < 4; ++m) { float* rowp = O + (size_t)(row0 + ai * HALF + m * 16) * ldc + col0;
#pragma unroll
                for (int bj = 0; bj < 2; ++bj)
#pragma unroll
                    for (int n = 0; n < 2; ++n) *(f32x4*)(rowp + bj * HALF + n * 16) = acc[ai][bj][m][n]; }
    }
};

template <int ACT  > struct EpiBf16 {
    static constexpr bool PERM = true, AFTER_DRAIN = false;
    bf16_t* O; int ldc; int split_cols; size_t split_stride;
    __device__ __forceinline__ void operator()(const f32x4 (&acc)[2][2][4][2], const Unit& u, int wr, int wc, int fr, int fq) const {
        const int row0 = u.pm * BM + wr * 64 + fr; int colt = u.pn * BM; bf16_t* base = O;
        if (split_cols) { const int t = colt / split_cols; base += (size_t)t * split_stride; colt -= t * split_cols; }
        const int col0 = colt + wc * 32 + 8 * fq;
#pragma unroll
        for (int ai = 0; ai < 2; ++ai)
#pragma unroll
            for (int m = 0; m < 4; ++m) { bf16_t* rowp = base + (size_t)(row0 + ai * HALF + m * 16) * ldc + col0;
#pragma unroll
                for (int bj = 0; bj < 2; ++bj) { f32x4 v0 = acc[ai][bj][m][0], v1 = acc[ai][bj][m][1];
                    if (ACT == 1) { v0 = silu4(v0); v1 = silu4(v1); }
                    *(u32x4*)(rowp + bj * HALF) = pk8(v0, v1); } }
    }
};

struct EpiSwiGLU {
    static constexpr bool PERM = true, AFTER_DRAIN = false;
    bf16_t* H; int ldc;
    __device__ __forceinline__ void operator()(const f32x4 (&acc)[2][2][4][2], const Unit& u, int wr, int wc, int fr, int fq) const {
        const int row0 = u.pm * BM + wr * 64 + fr, col0 = u.pn * HALF + wc * 32 + 8 * fq;
#pragma unroll
        for (int ai = 0; ai < 2; ++ai)
#pragma unroll
            for (int m = 0; m < 4; ++m) { bf16_t* rowp = H + (size_t)(row0 + ai * HALF + m * 16) * ldc + col0;
                const f32x4 v0 = silu4(acc[ai][0][m][0]) * acc[ai][1][m][0], v1 = silu4(acc[ai][0][m][1]) * acc[ai][1][m][1];
                *(u32x4*)rowp = pk8(v0, v1); }
    }
};

struct EpiQKV {
    static constexpr bool PERM = false, AFTER_DRAIN = false;
    bf16_t* Q; bf16_t* KALL; bf16_t* VALL; float* outk; float* outv; const float* rope; int nqt, nkt, ldq, ldk; float qscale;
    __device__ __forceinline__ void operator()(const f32x4 (&acc)[2][2][4][2], const Unit& u, int wr, int wc, int fr, int fq) const {
        const int which = u.pn < nqt ? 0 : (u.pn < nqt + nkt ? 1 : 2);
        const int colt = (which == 0 ? u.pn : which == 1 ? u.pn - nqt : u.pn - nqt - nkt) * BM + wc * 32 + 4 * fq;
        const bool lat = u.pm >= 16;
        const int krow0 = keyrow_of_tile(u.pm);
#pragma unroll
        for (int ai = 0; ai < 2; ++ai)
#pragma unroll
            for (int m = 0; m < 4; ++m) {
                const int rl = ai * HALF + wr * 64 + m * 16 + fr, row = u.pm * BM + rl;
                f32x4 cs = (f32x4){1.f, 1.f, 1.f, 1.f}, sn = (f32x4){0.f, 0.f, 0.f, 0.f};
                if (lat && which < 2) { const int tl = (row - 4096) & 1023, pos = (wc & 1) ? (tl & 63) : (tl >> 6);
                    cs = *(const f32x4*)(rope + pos * 16 + 4 * fq); sn = *(const f32x4*)(rope + 1024 + pos * 16 + 4 * fq); }
#pragma unroll
                for (int bj = 0; bj < 2; ++bj) {
                    const f32x4 x1 = acc[ai][bj][m][0], x2 = acc[ai][bj][m][1];
                    f32x4 o1 = x1, o2 = x2;
                    if (which < 2) { o1 = x1 * cs - x2 * sn; o2 = x2 * cs + x1 * sn; }
                    const int col = colt + bj * HALF;
                    if (which == 0) { o1 = o1 * qscale; o2 = o2 * qscale; bf16_t* p = Q + (size_t)row * ldq + col; *(u32x2*)p = pk4(o1); *(u32x2*)(p + 16) = pk4(o2); }
                    else { bf16_t* p = (which == 1 ? KALL : VALL) + (size_t)(krow0 + rl) * ldk + col; *(u32x2*)p = pk4(o1); *(u32x2*)(p + 16) = pk4(o2);
                        if (!lat) { float* f = (which == 1 ? outk : outv) + (size_t)row * ldk + col; *(f32x4*)f = o1; *(f32x4*)(f + 16) = o2; } }
                }
            }
    }
};

struct EpiMlaQ {
    static constexpr bool PERM = false, AFTER_DRAIN = false;
    bf16_t* Q; const float* rope; float qscale;
    __device__ __forceinline__ void operator()(const f32x4 (&acc)[2][2][4][2], const Unit& u, int wr, int wc, int fr, int fq) const {
        const bool lat = u.pm >= 16;
#pragma unroll
        for (int ai = 0; ai < 2; ++ai)
#pragma unroll
            for (int m = 0; m < 4; ++m) {
                const int row = u.pm * BM + ai * HALF + wr * 64 + m * 16 + fr; const int tl = (row - 4096) & 1023;
#pragma unroll
                for (int bj = 0; bj < 2; ++bj) {
                    const int G = u.pn * 8 + bj * 4 + wc, gm = G % 6;
                    const f32x4 x1 = acc[ai][bj][m][0], x2 = acc[ai][bj][m][1];
                    f32x4 o1 = x1, o2 = x2;
                    if (lat && gm >= 4) { const int pos = (gm == 5) ? (tl & 63) : (tl >> 6);
                        const f32x4 cs = *(const f32x4*)(rope + pos * 16 + 4 * fq), sn = *(const f32x4*)(rope + 1024 + pos * 16 + 4 * fq);
                        o1 = x1 * cs - x2 * sn; o2 = x2 * cs + x1 * sn; }
                    o1 = o1 * qscale; o2 = o2 * qscale;
                    bf16_t* p = Q + (size_t)row * 3072 + G * 32 + 4 * fq; *(u32x2*)p = pk4(o1); *(u32x2*)(p + 16) = pk4(o2);
                }
            }
    }
};

struct EpiHgrnT {
    static constexpr bool PERM = true, AFTER_DRAIN = false;
    bf16_t* QT; bf16_t* VT; bf16_t* LF; bf16_t* KK; const float* lb;
    __device__ __forceinline__ void operator()(const f32x4 (&acc)[2][2][4][2], const Unit& u, int wr, int wc, int fr, int fq) const {
        const int which = u.pm >> 3;
        const int ch0 = (u.pm & 7) * BM + wr * 64 + fr, col0 = u.pn * BM + wc * 32 + 8 * fq;
#pragma unroll
        for (int ai = 0; ai < 2; ++ai)
#pragma unroll
            for (int m = 0; m < 4; ++m) { const int ch = ch0 + ai * HALF + m * 16; const size_t off = (size_t)ch * 8192 + col0;
                float lbv = 0.f; if (which >= 2) lbv = lb[(which - 2) * 2048 + ch];
#pragma unroll
                for (int bj = 0; bj < 2; ++bj) { f32x4 v0 = acc[ai][bj][m][0], v1 = acc[ai][bj][m][1];
                    if (which == 0) { *(u32x4*)(QT + off + bj * HALF) = pk8(silu4(v0), silu4(v1)); }
                    else if (which == 1) { *(u32x4*)(VT + off + bj * HALF) = pk8(v0, v1); }
                    else { f32x4 l0, l1, k0, k1;
#pragma unroll
                        for (int e = 0; e < 4; ++e) { const float f0 = lbv + (1.f - lbv) * sigmoidf_(v0[e]), f1 = lbv + (1.f - lbv) * sigmoidf_(v1[e]);
                            l0[e] = __builtin_amdgcn_logf(f0) * 0.6931471805599453f; l1[e] = __builtin_amdgcn_logf(f1) * 0.6931471805599453f; k0[e] = 1.f - f0; k1[e] = 1.f - f1; }
                        const size_t o2 = (size_t)(which - 2) * 2048 * 8192 + off + bj * HALF;
                        *(u32x4*)(LF + o2) = pk8(l0, l1); *(u32x4*)(KK + o2) = pk8(k0, k1); } } }
    }
};
template <class Epi, class Sched, bool ALIGN_EPI = false, bool SP2 = false>
__device__ __forceinline__ void gemm_phase(PG8_LAS unsigned char* lds, const Gemm g, const Sched& S, const Epi& E) {
    const int tid = threadIdx.x, wid = __builtin_amdgcn_readfirstlane(tid >> 6), lane = tid & 63, wr = wid >> 2, wc = wid & 3, fr = lane & 15, fq = lane >> 4;
    const int K = g.K, nt = K / BK;
    unsigned voffA[2], voffB[2];
#pragma unroll
    for (int i = 0; i < 2; ++i) { int R, C; stage_rc(tid * 16 + i * 8192, R, C); const int Rb = Epi::PERM ? ((R & ~31) + perm32(R & 31)) : R;
        voffA[i] = (unsigned)(R * K + C) * 2u; voffB[i] = (unsigned)(Rb * K + C) * 2u; }
    const size_t kstep = (size_t)(BK * 2);
    const size_t hstep = (size_t)HALF * K * 2;
    const size_t tstep = 2 * hstep;
    const unsigned ldsw = (unsigned)wid * 1024u;
    const int aoff = lds_byte(wr * 64 + fr, fq * 8), boff = lds_byte(wc * 32 + fr, fq * 8);
#define PG8_SA(b, h) (((b) * 2 + (h)) * HTB)
#define PG8_SB(b, h) ((4 + (b) * 2 + (h)) * HTB)
#define PG8_STAGE(bufoff, gbase, voff) do { _Pragma("unroll") for (int _i = 0; _i < 2; ++_i) \
        __builtin_amdgcn_global_load_lds((const unsigned*)((const char*)(gbase) + (voff)[_i]), (PG8_LAS unsigned*)(lds + (bufoff) + ldsw + _i * 8192), 16, 0, 0); } while (0)
#define PG8_LDA(dst, b, h) do { _Pragma("unroll") for (int m = 0; m < 4; ++m) _Pragma("unroll") for (int k = 0; k < 2; ++k) dst[m][k] = *(const PG8_LAS bf16x8*)(lds + PG8_SA(b, h) + aoff + m * 2048 + k * 1024); } while (0)
#define PG8_LDB(dst, b, h) do { _Pragma("unroll") for (int n = 0; n < 2; ++n) _Pragma("unroll") for (int k = 0; k < 2; ++k) dst[n][k] = *(const PG8_LAS bf16x8*)(lds + PG8_SB(b, h) + boff + n * 2048 + k * 1024); } while (0)
#define PG8_MMA(ai, bj, At, Bt) do { __builtin_amdgcn_s_setprio(1); _Pragma("unroll") for (int m = 0; m < 4; ++m) _Pragma("unroll") for (int n = 0; n < 2; ++n) _Pragma("unroll") for (int k = 0; k < 2; ++k) \
        acc[ai][bj][m][n] = __builtin_amdgcn_mfma_f32_16x16x32_bf16(Bt[n][k], At[m][k], acc[ai][bj][m][n], 0, 0, 0); __builtin_amdgcn_s_setprio(0); } while (0)
#define PG8_WAIT_V(n) asm volatile("s_waitcnt vmcnt(" #n ")" ::: "memory")
#define PG8_WAIT_L(n) asm volatile("s_waitcnt lgkmcnt(" #n ")" ::: "memory")
#define PG8_BAR __builtin_amdgcn_s_barrier()
#define PG8_SCHED __builtin_amdgcn_sched_barrier(0)
    Unit cur, nxt; int ui = 0;
    if (!S.next(0, cur)) return;
    f32x4 acc[2][2][4][2];
#pragma unroll
    for (int a = 0; a < 2; ++a)
#pragma unroll
        for (int b = 0; b < 2; ++b)
#pragma unroll
            for (int m = 0; m < 4; ++m)
#pragma unroll
                for (int n = 0; n < 2; ++n) acc[a][b][m][n] = (f32x4){0.f, 0.f, 0.f, 0.f};
    bf16x8 At[4][2], B0[2][2], B1[2][2];
    const char* cA = (const char*)g.A + (size_t)cur.pm * tstep; const char* cB = (const char*)g.Bt + (size_t)cur.pn * tstep;
    S.a_ready(cur);
    if constexpr (SP2) {
        PG8_STAGE(PG8_SB(0, 0), cB, voffB); PG8_STAGE(PG8_SB(0, 1), cB + hstep, voffB); PG8_STAGE(PG8_SA(0, 0), cA, voffA); PG8_STAGE(PG8_SA(0, 1), cA + hstep, voffA);
        if (wr == 1) PG8_BAR;
        PG8_WAIT_V(2); PG8_BAR;
        PG8_STAGE(PG8_SB(1, 0), cB + kstep, voffB); PG8_STAGE(PG8_SA(1, 0), cA + kstep, voffA); PG8_STAGE(PG8_SB(1, 1), cB + hstep + kstep, voffB);
        PG8_WAIT_V(6); PG8_BAR;
    } else {
        PG8_STAGE(PG8_SB(0, 0), cB, voffB); PG8_STAGE(PG8_SA(0, 0), cA, voffA); PG8_STAGE(PG8_SB(0, 1), cB + hstep, voffB); PG8_STAGE(PG8_SA(0, 1), cA + hstep, voffA);
        if (wr == 1) PG8_BAR;
        PG8_WAIT_V(4); PG8_BAR;
        PG8_STAGE(PG8_SB(1, 0), cB + kstep, voffB); PG8_STAGE(PG8_SA(1, 0), cA + kstep, voffA); PG8_STAGE(PG8_SB(1, 1), cB + hstep + kstep, voffB);
        PG8_WAIT_V(6); PG8_BAR;
    }
    for (;;) {
        const bool has_next = S.next(ui + 1, nxt);
        const char* nA = has_next ? (const char*)g.A + (size_t)nxt.pm * tstep : cA; const char* nB = has_next ? (const char*)g.Bt + (size_t)nxt.pn * tstep : cB;
        for (int t = 0; t < nt; t += 2) {
            const bool last = (t == nt - 2);
            const char* a1 = cA + (size_t)(t + 1) * kstep;
            const char* a2 = last ? nA : cA + (size_t)(t + 2) * kstep; const char* b2 = last ? nB : cB + (size_t)(t + 2) * kstep;
            const char* a3 = a2 + kstep; const char* b3 = b2 + kstep;
            if (last && has_next) S.a_ready(nxt);
            if constexpr (SP2) {
            PG8_LDB(B0, 0, 0); PG8_LDB(B1, 0, 1); PG8_SCHED; PG8_LDA(At, 0, 0); PG8_STAGE(PG8_SA(1, 1), a1 + hstep, voffA);
            PG8_WAIT_V(8); PG8_WAIT_L(0); PG8_BAR; PG8_MMA(0, 0, At, B0); PG8_MMA(0, 1, At, B1); PG8_BAR; PG8_SCHED;
            PG8_LDA(At, 0, 1); PG8_STAGE(PG8_SB(0, 0), b2, voffB); PG8_STAGE(PG8_SB(0, 1), b2 + hstep, voffB); PG8_STAGE(PG8_SA(0, 0), a2, voffA);
            PG8_WAIT_V(8); PG8_WAIT_L(0); PG8_BAR; PG8_MMA(1, 0, At, B0); PG8_MMA(1, 1, At, B1); PG8_BAR; PG8_SCHED;
            PG8_LDB(B0, 1, 0); PG8_LDB(B1, 1, 1); PG8_SCHED; PG8_LDA(At, 1, 0); PG8_STAGE(PG8_SA(0, 1), a2 + hstep, voffA);
            PG8_WAIT_V(8); PG8_WAIT_L(0); PG8_BAR; PG8_MMA(0, 0, At, B0); PG8_MMA(0, 1, At, B1); PG8_BAR; PG8_SCHED;
            PG8_LDA(At, 1, 1); PG8_STAGE(PG8_SB(1, 0), b3, voffB); PG8_STAGE(PG8_SB(1, 1), b3 + hstep, voffB); PG8_STAGE(PG8_SA(1, 0), a3, voffA);
            PG8_WAIT_V(8); PG8_WAIT_L(0); PG8_BAR; PG8_MMA(1, 0, At, B0); PG8_MMA(1, 1, At, B1); PG8_BAR; PG8_SCHED;
            } else {
            PG8_LDB(B0, 0, 0); PG8_SCHED; PG8_LDA(At, 0, 0); PG8_STAGE(PG8_SA(1, 1), a1 + hstep, voffA);
            PG8_WAIT_L(8); PG8_BAR; PG8_WAIT_L(0); PG8_MMA(0, 0, At, B0); PG8_BAR; PG8_SCHED;
            PG8_LDB(B1, 0, 1); PG8_STAGE(PG8_SB(0, 0), b2, voffB);
            PG8_BAR; PG8_WAIT_L(0); PG8_MMA(0, 1, At, B1); PG8_BAR;
            PG8_LDA(At, 0, 1); PG8_STAGE(PG8_SA(0, 0), a2, voffA);
            PG8_BAR; PG8_WAIT_L(0); PG8_MMA(1, 0, At, B0); PG8_BAR; PG8_SCHED;
            PG8_STAGE(PG8_SB(0, 1), b2 + hstep, voffB);
            PG8_WAIT_V(6); PG8_BAR; PG8_MMA(1, 1, At, B1); PG8_BAR;
            PG8_LDB(B0, 1, 0); PG8_SCHED; PG8_LDA(At, 1, 0); PG8_STAGE(PG8_SA(0, 1), a2 + hstep, voffA);
            PG8_WAIT_L(8); PG8_BAR; PG8_WAIT_L(0); PG8_MMA(0, 0, At, B0); PG8_BAR; PG8_SCHED;
            PG8_LDB(B1, 1, 1); PG8_STAGE(PG8_SB(1, 0), b3, voffB);
            PG8_BAR; PG8_WAIT_L(0); PG8_MMA(0, 1, At, B1); PG8_BAR;
            PG8_LDA(At, 1, 1); PG8_STAGE(PG8_SA(1, 0), a3, voffA);
            PG8_BAR; PG8_WAIT_L(0); PG8_MMA(1, 0, At, B0); PG8_BAR; PG8_SCHED;
            PG8_STAGE(PG8_SB(1, 1), b3 + hstep, voffB);
            PG8_WAIT_V(6); PG8_BAR; PG8_MMA(1, 1, At, B1); PG8_BAR;
            }
        }
        if constexpr (ALIGN_EPI) { if (wr == 0) PG8_BAR; }
        if constexpr (!Epi::AFTER_DRAIN) { E(acc, cur, wr, wc, fr, fq); S.done(cur); }
        if (!has_next) break;
#pragma unroll
        for (int a = 0; a < 2; ++a)
#pragma unroll
            for (int b = 0; b < 2; ++b)
#pragma unroll
                for (int m = 0; m < 4; ++m)
#pragma unroll
                    for (int n = 0; n < 2; ++n) acc[a][b][m][n] = (f32x4){0.f, 0.f, 0.f, 0.f};
        cur = nxt; cA = nA; cB = nB; ++ui;
        if constexpr (ALIGN_EPI) { if (wr == 1) PG8_BAR; }
    }
    PG8_WAIT_V(0);
    if constexpr (!ALIGN_EPI) { if (wr == 0) PG8_BAR; }
    PG8_BAR;
    if constexpr (Epi::AFTER_DRAIN) { E.fused(acc, cur, wr, wc, fr, fq, lds, wid, lane); S.done(cur); }
#undef PG8_SA
#undef PG8_SB
#undef PG8_STAGE
#undef PG8_LDA
#undef PG8_LDB
#undef PG8_MMA
#undef PG8_WAIT_V
#undef PG8_WAIT_L
#undef PG8_BAR
#undef PG8_SCHED
}
}
#define LAS __attribute__((address_space(3)))
#define XB_TMO      128
#define XB_XCNT(j)  (256  + 64 * (j))
#define XB_XSUB(j)  (1280 + 64 * (j))
#define XB_XGEN(j)  (2304 + 64 * (j))
#define XB_TOP      3328
#define XB_TOPGEN   3392
#define XCD_BAR_WORDS 3456
#define XB_SPIN_CAP (1u << 18)

__device__ __forceinline__ unsigned xb_ld(unsigned* p)              { return __hip_atomic_load(p, __ATOMIC_RELAXED, __HIP_MEMORY_SCOPE_AGENT); }
__device__ __forceinline__ unsigned xb_add(unsigned* p, unsigned v) { return __hip_atomic_fetch_add(p, v, __ATOMIC_RELAXED, __HIP_MEMORY_SCOPE_AGENT); }
__device__ __forceinline__ unsigned xb_xcc_id() { return (unsigned)__builtin_amdgcn_s_getreg((3 << 11) | 20) & 0xFu; }
#define XB_SPIN(cond, bar) do { unsigned _sp = 0; while (cond) { __builtin_amdgcn_s_sleep(1); \
    if ((++_sp & 255u) == 0u) { if (xb_ld(&(bar)[XB_TMO])) break; if (_sp > XB_SPIN_CAP) { atomicAdd(&(bar)[XB_TMO], 1u); break; } } } } while (0)

struct XcdBarrier {
    unsigned* bar; unsigned x;
    volatile LAS unsigned* st;
};

__device__ __forceinline__ XcdBarrier xcd_barrier_post(unsigned* bar, volatile LAS unsigned* st) {
    XcdBarrier b; b.bar = bar; b.x = xb_xcc_id(); b.st = st;
    if (threadIdx.x == 0) (void)xb_add(&bar[XB_XCNT(b.x)], 1u);
    return b;
}
__device__ __forceinline__ void xcd_barrier_complete(unsigned* bar, unsigned x, unsigned& nloc, unsigned& nx) {
    const unsigned G = gridDim.x * gridDim.y * gridDim.z;
    unsigned sum, cnt, mine, sp = 0u;
    for (;;) {
        sum = 0u; cnt = 0u; mine = 0u;
#pragma unroll
        for (unsigned j = 0; j < 16; ++j) { const unsigned c = xb_ld(&bar[XB_XCNT(j)]); sum += c; cnt += (c > 0u) ? 1u : 0u; mine = (j == x) ? c : mine; }
        if (sum == G) break;
        __builtin_amdgcn_s_sleep(1);
        if ((++sp & 255u) == 0u) { if (xb_ld(&bar[XB_TMO])) break; if (sp > XB_SPIN_CAP) { atomicAdd(&bar[XB_TMO], 1u); break; } }
    }
    nloc = mine > 0u ? mine : 1u; nx = cnt > 0u ? cnt : 1u;
}

__device__ __forceinline__ void xcd_barrier(const XcdBarrier& b) {
    asm volatile("s_waitcnt vmcnt(0)" ::: "memory");
    __syncthreads();
    if (threadIdx.x == 0) {
        unsigned* bar = b.bar;
        __builtin_amdgcn_s_waitcnt(0);
        unsigned nloc = b.st[0], nx = b.st[1];
        if (nloc == 0u) { xcd_barrier_complete(bar, b.x, nloc, nx); b.st[0] = nloc; b.st[1] = nx; }
        const unsigned old = xb_add(&bar[XB_XSUB(b.x)], 1u);
        const unsigned gen = old / nloc;
        if (old + 1u == (gen + 1u) * nloc) {
            __builtin_amdgcn_fence(__ATOMIC_RELEASE, "agent");
            asm volatile("s_waitcnt vmcnt(0)" ::: "memory");
            const unsigned og = xb_add(&bar[XB_TOP], 1u);
            const unsigned tg = og / nx;
            if (og + 1u == (tg + 1u) * nx) xb_add(&bar[XB_TOPGEN], 1u);
            else XB_SPIN(xb_ld(&bar[XB_TOPGEN]) == tg, bar);
            __builtin_amdgcn_fence(__ATOMIC_ACQUIRE, "agent");
            xb_add(&bar[XB_XGEN(b.x)], 1u);
            asm volatile("s_waitcnt vmcnt(0)" ::: "memory");
        } else {
            XB_SPIN(xb_ld(&bar[XB_XGEN(b.x)]) == gen, bar);
            __builtin_amdgcn_fence(__ATOMIC_ACQUIRE, "agent");
            asm volatile("s_waitcnt vmcnt(0)" ::: "memory");
        }
    }
    __syncthreads();
}

constexpr int NWAVES = 8, NTHR = 512;
constexpr int DM = 2048, NTOK = 8192, NCTX = 4096, NKEY = 9216, DFF = 5632, MODW = 12288;
constexpr float EPS = 1e-6f, LOG2E = 1.4426950408889634f;
constexpr size_t OUT_Y = 0, OUT_AK = 16777216, OUT_AV = 25165824, OUT_BF = 33554432, OUT_BB = 37748736, OUT_CKV = 41943040, OUT_KPE = 42991616, OUT_DK = 43253760, OUT_DV = 44302336, OUT_END = 45350912;
enum { I_XP = 0, I_XS, I_CAK, I_CAV, I_SBF, I_SBB, I_CCKV, I_CKPE, I_CDK, I_CDV, I_C, I_CCTX, I_ADAW, I_ADAB, I_NMPRE, I_NMPOST, I_NFPRE, I_NFPOST,
       I_AWQ, I_AWK, I_AWV, I_AWO, I_ALAM, I_ASUBLN, I_BWQ, I_BWI, I_BWF, I_BLOWER, I_BWG, I_BGNORM, I_BWO,
       I_CWDQ, I_CQNORM, I_CWUQ, I_CWDKV, I_CKVNORM, I_CWUK, I_CWUV, I_CWO, I_DWQ, I_DWK, I_DWV, I_DSINK, I_DWO, I_FWG, I_FWU, I_FWD, N_IN };

constexpr size_t MiB = 1u << 20;
constexpr size_t WS_CTL = 0, CTL_ZERO_BYTES = 1 * MiB;
constexpr size_t WS_MOD = 1 * MiB;
constexpr size_t WS_ROPE = 2 * MiB;
constexpr size_t WS_LBT = 2 * MiB + 16384;
constexpr size_t WS_A_WQKV = 4 * MiB;
constexpr size_t WS_A_WO = WS_A_WQKV + 24 * MiB;
constexpr size_t WS_B_WP = WS_A_WO + 8 * MiB;
constexpr size_t WS_B_WG = WS_B_WP + 32 * MiB;
constexpr size_t WS_B_WO = WS_B_WG + 8 * MiB;
constexpr size_t WS_C_WD = WS_B_WO + 8 * MiB;
constexpr size_t WS_C_WUQ = WS_C_WD + 4 * MiB;
constexpr size_t WS_C_WUKV = WS_C_WUQ + 3 * MiB;
constexpr size_t WS_C_WO = WS_C_WUKV + 2 * MiB;
constexpr size_t WS_D_WQKV = WS_C_WO + 8 * MiB;
constexpr size_t WS_D_WO = WS_D_WQKV + 10 * MiB;
constexpr size_t WS_F_WGU = WS_D_WO + 8 * MiB;
constexpr size_t F_WGU_BYTES = 44 * MiB;
constexpr size_t WS_F_WD = WS_F_WGU + 4 * F_WGU_BYTES;
constexpr size_t F_WD_BYTES = 22 * MiB;
constexpr size_t WS_XN = WS_F_WD + 4 * F_WD_BYTES;
constexpr size_t WS_Y = WS_XN + 32 * MiB;
constexpr size_t WS_H = WS_Y + 64 * MiB;
constexpr size_t WS_A_KALL = WS_H + 88 * MiB;
constexpr size_t WS_A_VALL = WS_A_KALL + 36 * MiB;
constexpr size_t WS_C_CKVALL = WS_A_VALL + 36 * MiB;
constexpr size_t WS_C_KPEALL = WS_C_CKVALL + 5 * MiB;
constexpr size_t WS_D_KALL = WS_C_KPEALL + 2 * MiB;
constexpr size_t WS_D_VALL = WS_D_KALL + 5 * MiB;
constexpr size_t WS_MIX = WS_D_VALL + 5 * MiB;
constexpr size_t WS_A_Q = WS_MIX, WS_A_O = WS_MIX + 32 * MiB;
constexpr size_t WS_B_QT = WS_MIX, WS_B_VT = WS_MIX + 32 * MiB, WS_B_LF = WS_MIX + 64 * MiB, WS_B_KK = WS_MIX + 128 * MiB, WS_B_G = WS_MIX + 192 * MiB, WS_B_OT = WS_MIX + 224 * MiB, WS_B_O = WS_MIX + 352 * MiB;
constexpr size_t WS_C_QD = WS_MIX, WS_C_QDN = WS_MIX + 32 * MiB, WS_C_Q = WS_MIX + 40 * MiB, WS_C_KN = WS_MIX + 88 * MiB, WS_C_VV = WS_MIX + 124 * MiB, WS_C_O = WS_MIX + 160 * MiB;
constexpr size_t WS_D_Q = WS_MIX, WS_D_O = WS_MIX + 32 * MiB;
constexpr size_t WS_END = WS_MIX + 384 * MiB;
constexpr int CW_TMO = 0, CW_CODE = 1, CW_BAR = 4096;

constexpr int RING_OFF = 0, RING_BYTES = 131072;
constexpr int LDSCTL_OFF = RING_BYTES, MISC_OFF = LDSCTL_OFF + 320;
constexpr int LDS_BYTES = 147456;

#define GAS __attribute__((address_space(1)))
typedef unsigned short bf16;
typedef unsigned v4u __attribute__((ext_vector_type(4)));
typedef unsigned v2u __attribute__((ext_vector_type(2)));
typedef float f32x4 __attribute__((ext_vector_type(4)));
typedef float f32x16 __attribute__((ext_vector_type(16)));
typedef short bf16x8 __attribute__((ext_vector_type(8)));
typedef short s16x4 __attribute__((ext_vector_type(4)));
typedef GAS unsigned gu32;
#define RLX_AGENT __ATOMIC_RELAXED, __HIP_MEMORY_SCOPE_AGENT
using pg8::cvt_pk_bf16; using pg8::pk4; using pg8::pk8; using pg8::fast_exp; using pg8::siluf_; using pg8::sigmoidf_;
__device__ __forceinline__ float bf2f(unsigned short b) { return __uint_as_float((unsigned)b << 16); }
__device__ __forceinline__ float bflo(unsigned w) { return __uint_as_float(w << 16); }
__device__ __forceinline__ float bfhi(unsigned w) { return __uint_as_float(w & 0xffff0000u); }
__device__ __forceinline__ float wave_sum(float v) {
#pragma unroll
    for (int o = 1; o < 64; o <<= 1) v += __shfl_xor(v, o);
    return v;
}

struct Args { const float* in[N_IN]; float* out; unsigned char* ws; int ph_lo, ph_hi; };

__device__ __forceinline__ void p0_ada(const Args& a, LAS unsigned char* lds, int tid, int wave, int lane) {
    LAS float* sv = (LAS float*)lds;
    LAS float* red = (LAS float*)(lds + 40960);
    const float* c = a.in[I_C]; const float* cctx = a.in[I_CCTX];
    for (int i = tid; i < 5 * DM; i += NTHR) { const int r = i / DM, k = i % DM; const float v = r == 0 ? cctx[k] : c[(r - 1) * DM + k]; sv[i] = siluf_(v); }
    __syncthreads();
    float* MOD = (float*)(a.ws + WS_MOD);
    for (int item = blockIdx.x; item < 256; item += gridDim.x) {
        const int layer = item >> 6, cg = item & 63, k0 = 256 * wave; const bool active = lane < 48;
        const float* wp = a.in[I_ADAW] + ((size_t)layer * DM + k0) * MODW + 192 * cg + 4 * lane;
        f32x4 acc[5];
#pragma unroll
        for (int r = 0; r < 5; ++r) acc[r] = (f32x4){0.f, 0.f, 0.f, 0.f};
        if (active) {
            for (int kk = 0; kk < 256; kk += 8) {
                f32x4 wv[8];
#pragma unroll
                for (int u = 0; u < 8; ++u) wv[u] = __builtin_nontemporal_load((const f32x4*)(wp + (size_t)(kk + u) * MODW));
#pragma unroll
                for (int u = 0; u < 8; ++u)
#pragma unroll
                    for (int r = 0; r < 5; ++r) acc[r] += sv[r * DM + k0 + kk + u] * wv[u];
            }
#pragma unroll
            for (int r = 0; r < 5; ++r) *(LAS f32x4*)(red + (wave * 5 + r) * 192 + 4 * lane) = acc[r];
        }
        __syncthreads();
        for (int o = tid; o < 960; o += NTHR) { const int r = o / 192, cc = o % 192; float s = a.in[I_ADAB][layer * MODW + 192 * cg + cc];
#pragma unroll
            for (int w = 0; w < 8; ++w) s += red[(w * 5 + r) * 192 + cc];
            MOD[(size_t)(layer * 5 + r) * MODW + 192 * cg + cc] = s; }
        __syncthreads();
    }
}
__device__ __forceinline__ void transpose_item(const float* W, int N, bf16* WT, int ldt, int orow0, LAS float* scr, int k0, int n0, int lane) {
#pragma unroll 8
    for (int i = 0; i < 32; ++i) { const int kk = 2 * i + (lane >> 5); scr[kk * 33 + (lane & 31)] = __builtin_nontemporal_load(W + (size_t)(k0 + kk) * N + n0 + (lane & 31)); }
    asm volatile("s_waitcnt lgkmcnt(0)" ::: "memory");
    const int c = lane & 7;
#pragma unroll
    for (int j = 0; j < 4; ++j) { const int n = (lane >> 3) + 8 * j; const LAS float* s = scr + (8 * c) * 33 + n;
        v4u o; o.x = cvt_pk_bf16(s[0 * 33], s[1 * 33]); o.y = cvt_pk_bf16(s[2 * 33], s[3 * 33]); o.z = cvt_pk_bf16(s[4 * 33], s[5 * 33]); o.w = cvt_pk_bf16(s[6 * 33], s[7 * 33]);
        *(GAS v4u*)(WT + (size_t)(orow0 + n) * ldt + k0 + 8 * c) = o; }
    asm volatile("s_waitcnt lgkmcnt(0)" ::: "memory");
}
__device__ __forceinline__ void cvt_cache(const float* src, int W, bf16* dst, int gtid, int gthreads) {
    const int n4 = 4 * 256 * W / 4;
    for (int i = gtid; i < n4; i += gthreads) { const int e = 4 * i, b = e / (256 * W), rem = e % (256 * W), t = rem / W, cc = rem % W;
        const f32x4 v = *(const f32x4*)(src + e); *(v2u*)(dst + (size_t)(4096 + 1280 * b + t) * W + cc) = pk4(v); }
}
__device__ __forceinline__ void p0_prologue(const Args& a, LAS unsigned char* lds, int tid, int wave, int lane) {
    p0_ada(a, lds, tid, wave, lane);
    unsigned char* ws = a.ws;
    LAS float* scr = (LAS float*)(lds + wave * 16384);
    const int gw = blockIdx.x * NWAVES + wave, NGW = gridDim.x * NWAVES;
    constexpr int I_SQ = (DM / 64) * (DM / 32);
    constexpr int I_WDQ = (DM / 64) * (512 / 32), I_WDKV = (DM / 64) * (320 / 32), I_WUQ = (512 / 64) * (3072 / 32), I_WUK = (256 / 64) * (DM / 32), I_KV = (DM / 64) * (256 / 32);
    constexpr int I_FG = (DM / 64) * (DFF / 32), I_FD = (DFF / 64) * (DM / 32), I_FL = 2 * I_FG + I_FD;
    constexpr int NITEMS = 4 * I_SQ + 6 * I_SQ + (I_WDQ + I_WDKV + I_WUQ + 2 * I_WUK + I_SQ) + (I_SQ + 2 * I_KV + I_SQ) + 4 * I_FL;
#define TRI(SRC, KD, ND, DST, LDT, ROW0) { constexpr int ni_ = ((KD) / 64) * ((ND) / 32); if (r < ni_) { constexpr int nblk_ = (ND) / 32; const int kb_ = r / nblk_, n0 = 32 * (r % nblk_); \
        transpose_item((SRC), (ND), (bf16*)(DST), (LDT), (ROW0), scr, 64 * kb_, n0, lane); continue; } r -= ni_; }
    for (int it = gw; it < NITEMS; it += NGW) {
        int r = it;
        TRI(a.in[I_AWQ], DM, DM, ws + WS_A_WQKV, DM, n0)
        TRI(a.in[I_AWK], DM, DM, ws + WS_A_WQKV, DM, 2048 + n0)
        TRI(a.in[I_AWV], DM, DM, ws + WS_A_WQKV, DM, 4096 + n0)
        TRI(a.in[I_AWO], DM, DM, ws + WS_A_WO, DM, n0)
        TRI(a.in[I_BWQ], DM, DM, ws + WS_B_WP, DM, n0)
        TRI(a.in[I_BWI], DM, DM, ws + WS_B_WP, DM, 2048 + n0)
        TRI(a.in[I_BWF], DM, DM, ws + WS_B_WP, DM, 4096 + n0)
        TRI(a.in[I_BWF] + (size_t)DM * DM, DM, DM, ws + WS_B_WP, DM, 6144 + n0)
        TRI(a.in[I_BWG], DM, DM, ws + WS_B_WG, DM, n0)
        TRI(a.in[I_BWO], DM, DM, ws + WS_B_WO, DM, n0)
        TRI(a.in[I_CWDQ], DM, 512, ws + WS_C_WD, DM, n0)
        TRI(a.in[I_CWDKV], DM, 320, ws + WS_C_WD, DM, 512 + n0)
        TRI(a.in[I_CWUQ], 512, 3072, ws + WS_C_WUQ, 512, n0)
        TRI(a.in[I_CWUK], 256, DM, ws + WS_C_WUKV, 256, n0)
        TRI(a.in[I_CWUV], 256, DM, ws + WS_C_WUKV, 256, 2048 + n0)
        TRI(a.in[I_CWO], DM, DM, ws + WS_C_WO, DM, n0)
        TRI(a.in[I_DWQ], DM, DM, ws + WS_D_WQKV, DM, n0)
        TRI(a.in[I_DWK], DM, 256, ws + WS_D_WQKV, DM, 2048 + n0)
        TRI(a.in[I_DWV], DM, 256, ws + WS_D_WQKV, DM, 2304 + n0)
        TRI(a.in[I_DWO], DM, DM, ws + WS_D_WO, DM, n0)
        { const int l = r / I_FL; r -= l * I_FL;
          const float* wg = a.in[I_FWG] + (size_t)l * DM * DFF; const float* wu = a.in[I_FWU] + (size_t)l * DM * DFF; const float* wd = a.in[I_FWD] + (size_t)l * DFF * DM;
          unsigned char* gu = ws + WS_F_WGU + (size_t)l * F_WGU_BYTES; unsigned char* dd = ws + WS_F_WD + (size_t)l * F_WD_BYTES;
          TRI(wg, DM, DFF, gu, DM, 256 * (n0 >> 7) + (n0 & 127))
          TRI(wu, DM, DFF, gu, DM, 256 * (n0 >> 7) + 128 + (n0 & 127))
          TRI(wd, DFF, DM, dd, DFF, n0) }
    }
#undef TRI
    const int gtid = blockIdx.x * NTHR + tid, gthreads = gridDim.x * NTHR;
    { v4u* z = (v4u*)(ws + WS_C_WD + (size_t)832 * DM * 2); for (int i = gtid; i < 192 * DM * 2 / 16; i += gthreads) z[i] = (v4u){0u, 0u, 0u, 0u}; }
    cvt_cache(a.in[I_CAK], 2048, (bf16*)(ws + WS_A_KALL), gtid, gthreads);
    cvt_cache(a.in[I_CAV], 2048, (bf16*)(ws + WS_A_VALL), gtid, gthreads);
    cvt_cache(a.in[I_CCKV], 256, (bf16*)(ws + WS_C_CKVALL), gtid, gthreads);
    cvt_cache(a.in[I_CKPE], 64, (bf16*)(ws + WS_C_KPEALL), gtid, gthreads);
    cvt_cache(a.in[I_CDK], 256, (bf16*)(ws + WS_D_KALL), gtid, gthreads);
    cvt_cache(a.in[I_CDV], 256, (bf16*)(ws + WS_D_VALL), gtid, gthreads);
    if (gtid < 1024) { const int pos = gtid >> 4, j = gtid & 15; const float inv = __builtin_amdgcn_exp2f(-(float)j * 0.8304820237218406f);
        const float rev = (float)pos * inv * 0.15915494309189535f; float* R = (float*)(ws + WS_ROPE); R[gtid] = __builtin_amdgcn_cosf(rev); R[1024 + gtid] = __builtin_amdgcn_sinf(rev); }
    if (gtid >= 1024 && gtid < 1024 + 4096) { const int i = gtid - 1024; const float* bl = a.in[I_BLOWER];
        const float v0 = bl[i], v1 = bl[4096 + i], v2 = bl[8192 + i], v3 = bl[12288 + i]; const float mx = fmaxf(fmaxf(v0, v1), fmaxf(v2, v3));
        const float e0 = fast_exp(v0 - mx), e1 = fast_exp(v1 - mx), e2 = fast_exp(v2 - mx), e3 = fast_exp(v3 - mx);
        ((float*)(ws + WS_LBT))[i] = e1 / (e0 + e1 + e2 + e3); }
}

template <bool HAS_Y, bool HAS_NEXT>
__device__ __forceinline__ void nr_phase(const float* xp, const float* xs, float* xout, const float* Y, const float* gate, const float* gpost,
                                         const float* gpre, const float* shift, const float* scale, bf16* XN, int wave, int lane) {
    const int gw = blockIdx.x * NWAVES + wave, NGW = gridDim.x * NWAVES;
    for (int m = gw; m < NTOK; m += NGW) {
        const int cond = m < NCTX ? 0 : 1 + ((m - NCTX) >> 10);
        const float* xr = m < NCTX ? xp + (size_t)m * DM : xs + (size_t)(m - NCTX) * DM;
        f32x4 x[8];
#pragma unroll
        for (int j = 0; j < 8; ++j) x[j] = *(const f32x4*)(xr + 4 * lane + 256 * j);
        if (HAS_Y) {
            f32x4 y[8]; float ss = 0.f;
#pragma unroll
            for (int j = 0; j < 8; ++j) { y[j] = *(const f32x4*)(Y + (size_t)m * DM + 4 * lane + 256 * j); ss += (y[j][0] * y[j][0] + y[j][1] * y[j][1]) + (y[j][2] * y[j][2] + y[j][3] * y[j][3]); }
            const float r = __builtin_amdgcn_rsqf(wave_sum(ss) * (1.0f / DM) + EPS);
#pragma unroll
            for (int j = 0; j < 8; ++j) { const int e = 4 * lane + 256 * j; const f32x4 g = *(const f32x4*)(gate + (size_t)cond * MODW + e), gp = *(const f32x4*)(gpost + e);
                x[j] += g * (y[j] * r * gp); *(f32x4*)(xout + (size_t)m * DM + e) = x[j]; }
        }
        if (HAS_NEXT) {
            float ss = 0.f;
#pragma unroll
            for (int j = 0; j < 8; ++j) ss += (x[j][0] * x[j][0] + x[j][1] * x[j][1]) + (x[j][2] * x[j][2] + x[j][3] * x[j][3]);
            const float r = __builtin_amdgcn_rsqf(wave_sum(ss) * (1.0f / DM) + EPS);
#pragma unroll
            for (int j = 0; j < 8; ++j) { const int e = 4 * lane + 256 * j; const f32x4 gp = *(const f32x4*)(gpre + e), sc = *(const f32x4*)(scale + (size_t)cond * MODW + e), sh = *(const f32x4*)(shift + (size_t)cond * MODW + e);
                const f32x4 h = x[j] * r * gp * (1.0f + sc) + sh; *(v2u*)(XN + (size_t)m * DM + e) = pk4(h); }
        }
    }
}

__device__ __forceinline__ int crow(int r, int h) { return (r & 3) + 8 * (r >> 2) + 4 * h; }
__device__ __forceinline__ s16x4 vtr(LAS const unsigned char* p) { return __builtin_bit_cast(s16x4, __builtin_amdgcn_ds_read_tr16_b64_v4i16((LAS s16x4*)p)); }
#define MFMA32(a, b, c) __builtin_amdgcn_mfma_f32_32x32x16_bf16((a), (b), (c), 0, 0, 0)
constexpr float NEG_BIG = -1e30f;
__device__ __forceinline__ unsigned launder(unsigned x) { asm volatile("" : "+v"(x)); return x; }

template <int DK, int DV, int KPE, int MASK>
struct AttnCfg {
    static constexpr int KSTR = DK * 2 + 16, VSTR = DV * 2 + 64, KBUF = 64 * KSTR, VBUF = 64 * VSTR, BUF = KBUF + VBUF, WSF = 2 * BUF, TOTAL = WSF + 8 * 256;
    static constexpr int DKM = DK - KPE;
    static constexpr int KCH = DKM / 8, NKL = 64 * KCH / NTHR;
    static constexpr int PCH = KPE ? KPE / 8 : 1, NPL = (KPE ? 64 * PCH / NTHR : 0);
    static constexpr int VCH = DV / 8, NVL = 64 * VCH / NTHR;
    static_assert(TOTAL <= RING_BYTES, "attention LDS");
    static_assert(DK != 64 || DV != 128 || TOTAL + 8 * 8192 <= RING_BYTES, "attention A parking");
};

template <int DK, int DV, int KPE, int MASK>
__device__ __forceinline__ void attn_core(LAS unsigned char* lds, const bf16* Qw, int ldq, const bf16* K, int ldk, const bf16* KP, int ldkp, const bf16* V, int ldv,
                                          int ntiles, int jlo, float m_init, float l_init, int qpos0, f32x16 (&o)[DV / 32], float& l_out, int tid, int wave, int lane) {
    typedef AttnCfg<DK, DV, KPE, MASK> C;
    tid = (int)launder((unsigned)threadIdx.x); lane = tid & 63;
    const int r32 = lane & 31, h = lane >> 5;
    LAS float* wsf = (LAS float*)(lds + C::WSF + wave * 256);
    bf16x8 qf[DK / 16];
#pragma unroll
    for (int s = 0; s < DK / 16; ++s) qf[s] = *(const bf16x8*)((const char*)Qw + (unsigned)((r32 * ldq + 16 * s + 8 * h) * 2));
#pragma unroll
    for (int cb = 0; cb < DV / 32; ++cb)
#pragma unroll
        for (int r = 0; r < 16; ++r) o[cb][r] = 0.f;
    float m = m_init, l = (h == 0) ? l_init : 0.f;
    v4u kreg[C::NKL], vreg[C::NVL]; v4u preg[C::NPL > 0 ? C::NPL : 1];
#define ATT_TILE_ROW(ti) ((MASK && (ti) >= 4) ? 256 + 64 * (jlo + (ti) - 4) : 64 * (ti))
#define ATT_ISSUE(ti) do { const int kr_ = ATT_TILE_ROW(ti); \
        _Pragma("unroll") for (int i = 0; i < C::NKL; ++i) { const int idx = tid + NTHR * i, row = idx / C::KCH, ch = idx % C::KCH; kreg[i] = *(const v4u*)((const char*)K + (unsigned)(((kr_ + row) * ldk + 8 * ch) * 2)); } \
        if constexpr (KPE > 0) { _Pragma("unroll") for (int i = 0; i < C::NPL; ++i) { const int idx = tid + NTHR * i, row = idx / C::PCH, ch = idx % C::PCH; preg[i] = *(const v4u*)((const char*)KP + (unsigned)(((kr_ + row) * ldkp + 8 * ch) * 2)); } } \
        _Pragma("unroll") for (int i = 0; i < C::NVL; ++i) { const int idx = tid + NTHR * i, row = idx / C::VCH, ch = idx % C::VCH; vreg[i] = *(const v4u*)((const char*)V + (unsigned)(((kr_ + row) * ldv + 8 * ch) * 2)); } } while (0)
#define ATT_COMMIT(buf_) do { LAS unsigned char* kb_ = lds + (buf_) * C::BUF; LAS unsigned char* vb_ = kb_ + C::KBUF; \
        _Pragma("unroll") for (int i = 0; i < C::NKL; ++i) { const int idx = tid + NTHR * i, row = idx / C::KCH, ch = idx % C::KCH; *(LAS v4u*)(kb_ + row * C::KSTR + 16 * ch) = kreg[i]; } \
        if constexpr (KPE > 0) { _Pragma("unroll") for (int i = 0; i < C::NPL; ++i) { const int idx = tid + NTHR * i, row = idx / C::PCH, ch = idx % C::PCH; *(LAS v4u*)(kb_ + row * C::KSTR + C::DKM * 2 + 16 * ch) = preg[i]; } } \
        _Pragma("unroll") for (int i = 0; i < C::NVL; ++i) { const int idx = tid + NTHR * i, row = idx / C::VCH, ch = idx % C::VCH; *(LAS v4u*)(vb_ + row * C::VSTR + 16 * ch) = vreg[i]; } } while (0)
    ATT_ISSUE(0); ATT_COMMIT(0);
    __syncthreads();
    const int i16 = lane & 15, tq = i16 >> 2, tp = i16 & 3, cbk = (lane >> 4) & 1;
    const int voff = (4 * h + tq) * C::VSTR + (16 * cbk + 4 * tp) * 2;
    const int koff = r32 * C::KSTR + 16 * h;
    for (int ti = 0; ti < ntiles; ++ti) {
        const int buf = ti & 1;
        if (ti + 1 < ntiles) ATT_ISSUE(ti + 1);
        bool need = true, domask = false;
        if (MASK && ti >= 4) { const int k0 = 64 * (jlo + ti - 4); need = (k0 + 63 >= qpos0 - 128) && (k0 <= qpos0 + 31 + 128); domask = !((k0 + 63 - qpos0 <= 128) && (qpos0 + 31 - k0 <= 128)); }
        if (need) {
            LAS const unsigned char* kb = lds + buf * C::BUF; LAS const unsigned char* vb = kb + C::KBUF;
            f32x16 p0, p1;
#pragma unroll
            for (int r = 0; r < 16; ++r) { p0[r] = 0.f; p1[r] = 0.f; }
#pragma unroll
            for (int s = 0; s < DK / 16; ++s) {
                const bf16x8 k0f = *(LAS const bf16x8*)(kb + koff + 32 * s), k1f = *(LAS const bf16x8*)(kb + koff + 32 * C::KSTR + 32 * s);
                p0 = MFMA32(k0f, qf[s], p0); p1 = MFMA32(k1f, qf[s], p1);
            }
            if (MASK) { if (domask) { const int k0 = 64 * (jlo + ti - 4), qp = qpos0 + r32;
#pragma unroll
                for (int r = 0; r < 16; ++r) { const int kp = k0 + crow(r, h); int d0 = qp - kp; d0 = d0 < 0 ? -d0 : d0; int d1 = qp - kp - 32; d1 = d1 < 0 ? -d1 : d1;
                    if (d0 > 128) p0[r] = NEG_BIG; if (d1 > 128) p1[r] = NEG_BIG; } } }
            float mx = fmaxf(p0[0], p1[0]);
#pragma unroll
            for (int r = 1; r < 16; ++r) mx = fmaxf(mx, fmaxf(p0[r], p1[r]));
            mx = fmaxf(mx, __shfl_xor(mx, 32));
            const float mn = fmaxf(m, mx);
            if (__any(mn > m)) {
                const float alpha = __builtin_amdgcn_exp2f(m - mn); l *= alpha; m = mn;
                if (h == 0) wsf[r32] = alpha;
                asm volatile("s_waitcnt lgkmcnt(0)" ::: "memory");
#pragma unroll
                for (int g4 = 0; g4 < 4; ++g4) { const f32x4 f = *(LAS const f32x4*)(wsf + 8 * g4 + 4 * h);
#pragma unroll
                    for (int cb = 0; cb < DV / 32; ++cb) { o[cb][4 * g4] *= f[0]; o[cb][4 * g4 + 1] *= f[1]; o[cb][4 * g4 + 2] *= f[2]; o[cb][4 * g4 + 3] *= f[3]; } }
            }
            float ls = 0.f;
#pragma unroll
            for (int r = 0; r < 16; ++r) { p0[r] = __builtin_amdgcn_exp2f(p0[r] - m); p1[r] = __builtin_amdgcn_exp2f(p1[r] - m); ls += p0[r] + p1[r]; }
            l += ls;
            bf16x8 pa[4];
#pragma unroll
            for (int ks = 0; ks < 4; ++ks) { v4u w;
#pragma unroll
                for (int e = 0; e < 4; ++e) w[e] = (ks < 2) ? cvt_pk_bf16(p0[8 * (ks & 1) + 2 * e], p0[8 * (ks & 1) + 2 * e + 1]) : cvt_pk_bf16(p1[8 * (ks & 1) + 2 * e], p1[8 * (ks & 1) + 2 * e + 1]);
                pa[ks] = __builtin_bit_cast(bf16x8, w); }
#pragma unroll
            for (int cb = 0; cb < DV / 32; ++cb)
#pragma unroll
                for (int ks = 0; ks < 4; ++ks) {
                    const s16x4 lo = vtr(vb + voff + (16 * ks) * C::VSTR + 64 * cb), hi = vtr(vb + voff + (16 * ks + 8) * C::VSTR + 64 * cb);
                    const bf16x8 vf = __builtin_shufflevector(lo, hi, 0, 1, 2, 3, 4, 5, 6, 7);
                    o[cb] = MFMA32(pa[ks], vf, o[cb]);
                }
        }
        if (ti + 1 < ntiles) ATT_COMMIT(buf ^ 1);
        __syncthreads();
    }
    l_out = l + __shfl_xor(l, 32);
}

__device__ __forceinline__ void row_recip(LAS float* wsf, float l, int r32, int h, float (&rl)[16]) {
    if (h == 0) wsf[32 + r32] = __builtin_amdgcn_rcpf(l);
    asm volatile("s_waitcnt lgkmcnt(0)" ::: "memory");
#pragma unroll
    for (int g4 = 0; g4 < 4; ++g4) { const f32x4 f = *(LAS const f32x4*)(wsf + 32 + 8 * g4 + 4 * h); rl[4 * g4] = f[0]; rl[4 * g4 + 1] = f[1]; rl[4 * g4 + 2] = f[2]; rl[4 * g4 + 3] = f[3]; }
}

__device__ __forceinline__ void attn_phase_A(const Args& a, LAS unsigned char* lds, int tid, int wave, int lane) {
    typedef AttnCfg<64, 128, 0, 0> C;
    unsigned char* ws = a.ws;
    const bf16* Q = (const bf16*)(ws + WS_A_Q); const bf16* KA = (const bf16*)(ws + WS_A_KALL); const bf16* VA = (const bf16*)(ws + WS_A_VALL); bf16* O = (bf16*)(ws + WS_A_O);
    const int r32 = lane & 31, h = lane >> 5;
    LAS float* wsf = (LAS float*)(lds + C::WSF + wave * 256);
    const float* lp = a.in[I_ALAM];
    const float s1 = wave_sum(lp[lane] * lp[64 + lane]), s2 = wave_sum(lp[128 + lane] * lp[192 + lane]);
    const float lam_init = 0.2f, lam = fast_exp(s1) - fast_exp(s2) + lam_init;
    const float* subln = a.in[I_ASUBLN];
    const int G = gridDim.x, vcu = (G % 8 == 0) ? (blockIdx.x % 8) * (G / 8) + blockIdx.x / 8 : blockIdx.x;
    for (int u = vcu; u < 512; u += G) {
        int qrow0, krow0, ntiles, head;
        if (u < 256) { const int b = u >> 6; head = (u >> 2) & 15; const int qb = u & 3; qrow0 = NCTX + 1024 * b + 256 * qb; krow0 = NCTX + 1280 * b; ntiles = 20; }
        else { const int v = u - 256, b = v >> 4; head = v & 15; qrow0 = 256 * b; krow0 = 256 * b; ntiles = 4; }
        const int qw = qrow0 + 32 * wave;
        LAS v4u* park = (LAS v4u*)(lds + C::TOTAL + wave * 8192) + lane;
        { f32x16 ob[4]; float lb_;
          attn_core<64, 128, 0, 0>(lds, Q + (size_t)qw * DM + 128 * head + 64, DM, KA + (size_t)krow0 * DM + 128 * head + 64, DM, nullptr, 0, VA + (size_t)krow0 * DM + 128 * head, DM, ntiles, 0, NEG_BIG, 0.f, 0, ob, lb_, tid, wave, lane);
          float rl[16]; row_recip(wsf, lb_, r32, h, rl);
#pragma unroll
          for (int cb = 0; cb < 4; ++cb)
#pragma unroll
              for (int e4 = 0; e4 < 2; ++e4) { v4u w;
#pragma unroll
                  for (int e = 0; e < 4; ++e) { const int r = 8 * e4 + 2 * e; w[e] = cvt_pk_bf16(ob[cb][r] * (lam * rl[r]), ob[cb][r + 1] * (lam * rl[r + 1])); }
                  park[(cb * 2 + e4) * 64] = w; } }
        f32x16 oa[4]; float la;
        attn_core<64, 128, 0, 0>(lds, Q + (size_t)qw * DM + 128 * head, DM, KA + (size_t)krow0 * DM + 128 * head, DM, nullptr, 0, VA + (size_t)krow0 * DM + 128 * head, DM, ntiles, 0, NEG_BIG, 0.f, 0, oa, la, tid, wave, lane);
        float rl[16]; row_recip(wsf, la, r32, h, rl);
        float ss[16];
#pragma unroll
        for (int r = 0; r < 16; ++r) ss[r] = 0.f;
#pragma unroll
        for (int cb = 0; cb < 4; ++cb)
#pragma unroll
            for (int e4 = 0; e4 < 2; ++e4) { const v4u w = park[(cb * 2 + e4) * 64];
#pragma unroll
                for (int e = 0; e < 4; ++e) { const int r = 8 * e4 + 2 * e;
                    const float v0 = oa[cb][r] * rl[r] - bflo(w[e]), v1 = oa[cb][r + 1] * rl[r + 1] - bfhi(w[e]);
                    oa[cb][r] = v0; oa[cb][r + 1] = v1; ss[r] += v0 * v0; ss[r + 1] += v1 * v1; } }
#pragma unroll
        for (int r = 0; r < 16; ++r) { float s = ss[r]; s += __shfl_xor(s, 1); s += __shfl_xor(s, 2); s += __shfl_xor(s, 4); s += __shfl_xor(s, 8); s += __shfl_xor(s, 16);
            ss[r] = __builtin_amdgcn_rsqf(s * (1.0f / 128.0f) + EPS) * (1.0f - lam_init); }
        const unsigned lbase_ = launder((unsigned)((4 * h * DM + r32) * 2));
#pragma unroll
        for (int cb = 0; cb < 4; ++cb) { const float g = subln[32 * cb + r32];
#pragma unroll
            for (int r = 0; r < 16; ++r) { const float v = oa[cb][r] * ss[r] * g; *(bf16*)((char*)O + (lbase_ + (unsigned)(((qw + (r & 3) + 8 * (r >> 2)) * DM + 128 * head + 32 * cb) * 2))) = (bf16)(cvt_pk_bf16(v, 0.f) & 0xffffu); } }
    }
}

template <int NCB>
__device__ __forceinline__ void attn_store(bf16* O, int qw, int colbase, f32x16 (&o)[NCB], float l, LAS float* wsf, int r32, int h) {
    float rl[16]; row_recip(wsf, l, r32, h, rl);
    const unsigned lbase_ = launder((unsigned)((4 * h * DM + r32) * 2));
#pragma unroll
    for (int cb = 0; cb < NCB; ++cb)
#pragma unroll
        for (int r = 0; r < 16; ++r) { const float v = o[cb][r] * rl[r]; *(bf16*)((char*)O + (lbase_ + (unsigned)(((qw + (r & 3) + 8 * (r >> 2)) * DM + colbase + 32 * cb) * 2))) = (bf16)(cvt_pk_bf16(v, 0.f) & 0xffffu); }
}
__device__ __forceinline__ void attn_phase_C(const Args& a, LAS unsigned char* lds, int tid, int wave, int lane) {
    typedef AttnCfg<192, 128, 64, 0> C;
    unsigned char* ws = a.ws;
    const bf16* Q = (const bf16*)(ws + WS_C_Q); const bf16* KN = (const bf16*)(ws + WS_C_KN); const bf16* KP = (const bf16*)(ws + WS_C_KPEALL); const bf16* VV = (const bf16*)(ws + WS_C_VV); bf16* O = (bf16*)(ws + WS_C_O);
    const int r32 = lane & 31, h = lane >> 5;
    LAS float* wsf = (LAS float*)(lds + C::WSF + wave * 256);
    const int G = gridDim.x, vcu = (G % 8 == 0) ? (blockIdx.x % 8) * (G / 8) + blockIdx.x / 8 : blockIdx.x;
    for (int u = vcu; u < 512; u += G) {
        int qrow0, krow0, ntiles, head;
        if (u < 256) { const int b = u >> 6; head = (u >> 2) & 15; const int qb = u & 3; qrow0 = NCTX + 1024 * b + 256 * qb; krow0 = NCTX + 1280 * b; ntiles = 20; }
        else { const int v = u - 256, b = v >> 4; head = v & 15; qrow0 = 256 * b; krow0 = 256 * b; ntiles = 4; }
        const int qw = qrow0 + 32 * wave;
        f32x16 o[4]; float l;
        attn_core<192, 128, 64, 0>(lds, Q + (size_t)qw * 3072 + 192 * head, 3072, KN + (size_t)krow0 * DM + 128 * head, DM, KP + (size_t)krow0 * 64, 64, VV + (size_t)krow0 * DM + 128 * head, DM,
                                   ntiles, 0, NEG_BIG, 0.f, 0, o, l, tid, wave, lane);
        attn_store<4>(O, qw, 128 * head, o, l, wsf, r32, h);
    }
}
__device__ __forceinline__ void attn_phase_D(const Args& a, LAS unsigned char* lds, int tid, int wave, int lane) {
    typedef AttnCfg<64, 64, 0, 1> C;
    unsigned char* ws = a.ws;
    const bf16* Q = (const bf16*)(ws + WS_D_Q); const bf16* KA = (const bf16*)(ws + WS_D_KALL); const bf16* VA = (const bf16*)(ws + WS_D_VALL); bf16* O = (bf16*)(ws + WS_D_O);
    const int r32 = lane & 31, h = lane >> 5;
    LAS float* wsf = (LAS float*)(lds + C::WSF + wave * 256);
    const float* sink = a.in[I_DSINK];
    const int G = gridDim.x, vcu = (G % 8 == 0) ? (blockIdx.x % 8) * (G / 8) + blockIdx.x / 8 : blockIdx.x;
    for (int u = vcu; u < 1024; u += G) {
        int qrow0, krow0, ntiles, hq, jlo = 0, qpos0 = 0;
        if (u < 512) { const int b = u >> 7; hq = (u >> 2) & 31; const int qb = u & 3; qrow0 = NCTX + 1024 * b + 256 * qb; krow0 = NCTX + 1280 * b;
            jlo = qb == 0 ? 0 : 4 * qb - 2; const int jhi = (4 * qb + 5) < 15 ? (4 * qb + 5) : 15; ntiles = 4 + jhi - jlo + 1; qpos0 = 256 * qb + 32 * wave; }
        else { const int v = u - 512, b = v >> 5; hq = v & 31; qrow0 = 256 * b; krow0 = 256 * b; ntiles = 4; }
        const int qw = qrow0 + 32 * wave, kvh = hq >> 3;
        f32x16 o[2]; float l;
        attn_core<64, 64, 0, 1>(lds, Q + (size_t)qw * DM + 64 * hq, DM, KA + (size_t)krow0 * 256 + 64 * kvh, 256, nullptr, 0, VA + (size_t)krow0 * 256 + 64 * kvh, 256,
                                ntiles, jlo, sink[hq] * LOG2E, 1.0f, qpos0, o, l, tid, wave, lane);
        attn_store<2>(O, qw, 64 * hq, o, l, wsf, r32, h);
    }
}

constexpr int SC_STR = 80, SC_IMG = 128 * SC_STR, SC_QD = 0, SC_KI = SC_IMG, SC_KE = 2 * SC_IMG, SC_VT = 3 * SC_IMG, SC_EL = 4 * SC_IMG, SC_DIR = 4 * SC_IMG + 512;
static_assert(2 * SC_DIR <= RING_BYTES, "scan LDS");

__device__ __forceinline__ void scan_unit(const Args& a, LAS unsigned char* lds, int tok0, int T, int head, const float* st_f, const float* st_b, float* out_f, float* out_b, int tid, int wave, int lane) {
    unsigned char* ws = a.ws;
    const int dir = wave >> 2, wv = wave & 3, r32 = lane & 31, h = lane >> 5;
    const int td = tid & 255, dch = td & 127, g = td >> 7;
    const bf16* QTg = (const bf16*)(ws + WS_B_QT) + (size_t)(128 * head) * NTOK;
    const bf16* VTg = (const bf16*)(ws + WS_B_VT) + (size_t)(128 * head) * NTOK;
    const bf16* LFg = (const bf16*)(ws + WS_B_LF) + ((size_t)dir * DM + 128 * head) * NTOK;
    const bf16* KKg = (const bf16*)(ws + WS_B_KK) + ((size_t)dir * DM + 128 * head) * NTOK;
    float* OTg = (float*)(ws + WS_B_OT) + ((size_t)dir * DM + 128 * head) * NTOK;
    LAS unsigned char* L = lds + dir * SC_DIR;
    const int nch = T / 32;
    f32x16 S[4];
    { const float* st = dir ? st_b : st_f; const unsigned lb_ = launder((unsigned)((4 * h * 128 + 32 * wv + r32) * 4));
#pragma unroll
      for (int dt = 0; dt < 4; ++dt)
#pragma unroll
          for (int r = 0; r < 16; ++r) S[dt][r] = st ? *(const float*)((const char*)st + (lb_ + (unsigned)((32 * dt + (r & 3) + 8 * (r >> 2)) * 512))) : 0.f; }
    v4u lfr[4], kkr[2], qr[2], vr[2];
#define SC_LOAD(c_) do { const int ci_ = dir ? nch - 1 - (c_) : (c_); const size_t tk_ = (size_t)tok0 + 32 * ci_; \
        const v4u* p_ = (const v4u*)(LFg + (size_t)dch * NTOK + tk_); lfr[0] = p_[0]; lfr[1] = p_[1]; lfr[2] = p_[2]; lfr[3] = p_[3]; \
        p_ = (const v4u*)(KKg + (size_t)dch * NTOK + tk_ + 16 * g); kkr[0] = p_[0]; kkr[1] = p_[1]; \
        p_ = (const v4u*)(QTg + (size_t)dch * NTOK + tk_ + 16 * g); qr[0] = p_[0]; qr[1] = p_[1]; \
        p_ = (const v4u*)(VTg + (size_t)(td >> 1) * NTOK + tk_ + 16 * (td & 1)); vr[0] = p_[0]; vr[1] = p_[1]; } while (0)
    SC_LOAD(0);
    const int i16 = lane & 15, tq = i16 >> 2, tp = i16 & 3, cbk = (lane >> 4) & 1;
    const int troff = tq * SC_STR + (16 * cbk + 4 * tp) * 2;
    for (int c = 0; c < nch; ++c) {
        float bc[16], bL;
        { v4u mine[2], oth[2];
#pragma unroll
          for (int e = 0; e < 4; ++e) { mine[0][e] = g ? lfr[2][e] : lfr[0][e]; mine[1][e] = g ? lfr[3][e] : lfr[1][e]; oth[0][e] = g ? lfr[0][e] : lfr[2][e]; oth[1][e] = g ? lfr[1][e] : lfr[3][e]; }
          float other = 0.f;
#pragma unroll
          for (int i = 0; i < 2; ++i)
#pragma unroll
              for (int e = 0; e < 4; ++e) other += bflo(oth[i][e]) + bfhi(oth[i][e]);
          float own[16];
#pragma unroll
          for (int i = 0; i < 2; ++i)
#pragma unroll
              for (int e = 0; e < 4; ++e) { own[8 * i + 2 * e] = bflo(mine[i][e]); own[8 * i + 2 * e + 1] = bfhi(mine[i][e]); }
          if (dir == 0) { float acc = g ? other : 0.f;
#pragma unroll
              for (int s = 0; s < 16; ++s) { acc += own[s]; bc[s] = acc; }
              bL = g ? acc : acc + other; }
          else { float acc = g ? 0.f : other;
#pragma unroll
              for (int s = 15; s >= 0; --s) { acc += own[s]; bc[s] = acc; }
              bL = g ? acc + other : acc; } }
        { v4u wq[2], wi[2], we[2];
#pragma unroll
          for (int i = 0; i < 2; ++i)
#pragma unroll
              for (int e = 0; e < 4; ++e) {
                  const int s0 = 8 * i + 2 * e;
                  const float b0 = bc[s0], b1 = bc[s0 + 1];
                  const float e0 = fast_exp(b0), e1 = fast_exp(b1), i0 = fast_exp(-b0), i1 = fast_exp(-b1), x0 = fast_exp(bL - b0), x1 = fast_exp(bL - b1);
                  const float q0 = bflo(qr[i][e]), q1 = bfhi(qr[i][e]), k0 = bflo(kkr[i][e]), k1 = bfhi(kkr[i][e]);
                  wq[i][e] = cvt_pk_bf16(q0 * e0, q1 * e1); wi[i][e] = cvt_pk_bf16(k0 * i0, k1 * i1); we[i][e] = cvt_pk_bf16(k0 * x0, k1 * x1); }
          LAS unsigned char* row = L + dch * SC_STR + 32 * g;
          *(LAS v4u*)(row + SC_QD) = wq[0]; *(LAS v4u*)(row + SC_QD + 16) = wq[1];
          *(LAS v4u*)(row + SC_KI) = wi[0]; *(LAS v4u*)(row + SC_KI + 16) = wi[1];
          *(LAS v4u*)(row + SC_KE) = we[0]; *(LAS v4u*)(row + SC_KE + 16) = we[1];
          LAS unsigned char* vrow = L + SC_VT + (td >> 1) * SC_STR + 32 * (td & 1);
          *(LAS v4u*)vrow = vr[0]; *(LAS v4u*)(vrow + 16) = vr[1];
          if (g == 0) *(LAS float*)(L + SC_EL + 4 * dch) = fast_exp(bL); }
        if (c + 1 < nch) SC_LOAD(c + 1);
        __syncthreads();
        f32x16 pt;
#pragma unroll
        for (int r = 0; r < 16; ++r) pt[r] = 0.f;
#pragma unroll
        for (int ks = 0; ks < 8; ++ks) {
            const int ro = (16 * ks + 8 * h) * SC_STR + troff;
            const s16x4 a0 = vtr(L + SC_KI + ro), a1 = vtr(L + SC_KI + ro + 4 * SC_STR), b0 = vtr(L + SC_QD + ro), b1 = vtr(L + SC_QD + ro + 4 * SC_STR);
            pt = MFMA32(__builtin_shufflevector(a0, a1, 0, 1, 2, 3, 4, 5, 6, 7), __builtin_shufflevector(b0, b1, 0, 1, 2, 3, 4, 5, 6, 7), pt);
        }
#pragma unroll
        for (int r = 0; r < 16; ++r) { const int s = crow(r, h); const bool keep = dir ? (s >= r32) : (s <= r32); pt[r] = keep ? pt[r] : 0.f; }
        f32x16 o;
#pragma unroll
        for (int r = 0; r < 16; ++r) o[r] = 0.f;
        LAS const unsigned char* vrow = L + SC_VT + (32 * wv + r32) * SC_STR;
#pragma unroll
        for (int ks = 0; ks < 2; ++ks) { v4u w;
#pragma unroll
            for (int e = 0; e < 4; ++e) w[e] = cvt_pk_bf16(pt[8 * ks + 2 * e], pt[8 * ks + 2 * e + 1]);
            const v2u v0 = *(LAS const v2u*)(vrow + (16 * ks + 4 * h) * 2), v1 = *(LAS const v2u*)(vrow + (16 * ks + 4 * h) * 2 + 16);
            const v4u vv = (v4u){v0.x, v0.y, v1.x, v1.y};
            o = MFMA32(__builtin_bit_cast(bf16x8, w), __builtin_bit_cast(bf16x8, vv), o); }
#pragma unroll
        for (int dt = 0; dt < 4; ++dt)
#pragma unroll
            for (int ks = 0; ks < 2; ++ks) { v4u w;
#pragma unroll
                for (int e = 0; e < 4; ++e) w[e] = cvt_pk_bf16(S[dt][8 * ks + 2 * e], S[dt][8 * ks + 2 * e + 1]);
                const int ro = (32 * dt + 16 * ks + 4 * h) * SC_STR + troff;
                const s16x4 a0 = vtr(L + SC_QD + ro), a1 = vtr(L + SC_QD + ro + 8 * SC_STR);
                o = MFMA32(__builtin_shufflevector(a0, a1, 0, 1, 2, 3, 4, 5, 6, 7), __builtin_bit_cast(bf16x8, w), o); }
#pragma unroll
        for (int dt = 0; dt < 4; ++dt) {
#pragma unroll
            for (int g4 = 0; g4 < 4; ++g4) { const f32x4 f = *(LAS const f32x4*)(L + SC_EL + 4 * (32 * dt + 8 * g4 + 4 * h));
                S[dt][4 * g4] *= f[0]; S[dt][4 * g4 + 1] *= f[1]; S[dt][4 * g4 + 2] *= f[2]; S[dt][4 * g4 + 3] *= f[3]; }
#pragma unroll
            for (int ks = 0; ks < 2; ++ks) {
                const bf16x8 ak = *(LAS const bf16x8*)(L + SC_KE + (32 * dt + r32) * SC_STR + (16 * ks + 8 * h) * 2), bv = *(LAS const bf16x8*)(vrow + (16 * ks + 8 * h) * 2);
                S[dt] = MFMA32(ak, bv, S[dt]); }
        }
        { const int ci = dir ? nch - 1 - c : c; float* op = OTg + (size_t)(32 * wv + r32) * NTOK + tok0 + 32 * ci + 4 * h;
#pragma unroll
          for (int g4 = 0; g4 < 4; ++g4) *(f32x4*)(op + 8 * g4) = (f32x4){o[4 * g4], o[4 * g4 + 1], o[4 * g4 + 2], o[4 * g4 + 3]}; }
        __syncthreads();
    }
#undef SC_LOAD
    { float* so = dir ? out_b : out_f; const unsigned lb_ = launder((unsigned)((4 * h * 128 + 32 * wv + r32) * 4));
      if (so) {
#pragma unroll
          for (int dt = 0; dt < 4; ++dt)
#pragma unroll
              for (int r = 0; r < 16; ++r) *(float*)((char*)so + (lb_ + (unsigned)((32 * dt + (r & 3) + 8 * (r >> 2)) * 512))) = S[dt][r]; } }
    asm volatile("s_waitcnt vmcnt(0)" ::: "memory");
    __syncthreads();
    const float* OF = (const float*)(ws + WS_B_OT) + (size_t)(128 * head) * NTOK; const float* OB = OF + (size_t)DM * NTOK;
    const bf16* Gg = (const bf16*)(ws + WS_B_G); bf16* O = (bf16*)(ws + WS_B_O); const float* gn = a.in[I_BGNORM];
    for (int t = tid; t < T; t += NTHR) {
        const size_t tk = (size_t)tok0 + t; float ss = 0.f;
#pragma unroll 8
        for (int v = 0; v < 128; ++v) { const float x = OF[(size_t)v * NTOK + tk] + OB[(size_t)v * NTOK + tk]; ss += x * x; }
        const float rs = __builtin_amdgcn_rsqf(ss * (1.0f / 128.0f) + EPS);
#pragma unroll 2
        for (int j = 0; j < 16; ++j) { const v4u gv = *(const v4u*)(Gg + tk * DM + 128 * head + 8 * j); float x[8];
#pragma unroll
            for (int e = 0; e < 8; ++e) { const int v = 8 * j + e; x[e] = (OF[(size_t)v * NTOK + tk] + OB[(size_t)v * NTOK + tk]) * rs * gn[v]; }
            v4u w; w.x = cvt_pk_bf16(x[0] * bflo(gv.x), x[1] * bfhi(gv.x)); w.y = cvt_pk_bf16(x[2] * bflo(gv.y), x[3] * bfhi(gv.y));
            w.z = cvt_pk_bf16(x[4] * bflo(gv.z), x[5] * bfhi(gv.z)); w.w = cvt_pk_bf16(x[6] * bflo(gv.w), x[7] * bfhi(gv.w));
            *(v4u*)(O + tk * DM + 128 * head + 8 * j) = w; }
    }
    __syncthreads();
}

__device__ __forceinline__ void scan_phase(const Args& a, LAS unsigned char* lds, int tid, int wave, int lane) {
    const int G = gridDim.x, vcu = (G % 8 == 0) ? (blockIdx.x % 8) * (G / 8) + blockIdx.x / 8 : blockIdx.x;
    for (int u = vcu; u < 320; u += G) {
        if (u < 64) { const int b = u >> 4, head = u & 15;
            scan_unit(a, lds, NCTX + 1024 * b, 1024, head, a.in[I_SBF] + (size_t)(b * 16 + head) * 16384, a.in[I_SBB] + (size_t)(b * 16 + head) * 16384, nullptr, nullptr, tid, wave, lane); }
        else { const int v = u - 64, b = v >> 4, head = v & 15;
            scan_unit(a, lds, 256 * b, 256, head, nullptr, nullptr, a.out + OUT_BF + (size_t)(b * 16 + head) * 16384, a.out + OUT_BB + (size_t)(b * 16 + head) * 16384, tid, wave, lane); }
    }
}

__device__ __forceinline__ void mla_thin_phase(const Args& a, int wave, int lane) {
    unsigned char* ws = a.ws;
    const float* QD = (const float*)(ws + WS_C_QD); bf16* QDN = (bf16*)(ws + WS_C_QDN); bf16* CKV = (bf16*)(ws + WS_C_CKVALL); bf16* KPE = (bf16*)(ws + WS_C_KPEALL);
    const float* ROPE = (const float*)(ws + WS_ROPE); const float* qn = a.in[I_CQNORM]; const float* kvn = a.in[I_CKVNORM];
    const int gw = blockIdx.x * NWAVES + wave, NGW = gridDim.x * NWAVES;
    for (int m = gw; m < NTOK; m += NGW) {
        const bool lat = m >= NCTX; const int t = (m - NCTX) & 1023;
        const int kr = lat ? NCTX + 1280 * ((m - NCTX) >> 10) + 256 + t : m;
        const float* row = QD + (size_t)m * 1024;
        f32x4 v[4];
#pragma unroll
        for (int j = 0; j < 4; ++j) v[j] = *(const f32x4*)(row + 4 * lane + 256 * j);
        { float ss = 0.f;
#pragma unroll
          for (int j = 0; j < 2; ++j) ss += (v[j][0] * v[j][0] + v[j][1] * v[j][1]) + (v[j][2] * v[j][2] + v[j][3] * v[j][3]);
          const float rs = __builtin_amdgcn_rsqf(wave_sum(ss) * (1.0f / 512.0f) + EPS);
#pragma unroll
          for (int j = 0; j < 2; ++j) { const f32x4 g = *(const f32x4*)(qn + 4 * lane + 256 * j); *(v2u*)(QDN + (size_t)m * 512 + 4 * lane + 256 * j) = pk4(v[j] * rs * g); } }
        { const float ss = (v[2][0] * v[2][0] + v[2][1] * v[2][1]) + (v[2][2] * v[2][2] + v[2][3] * v[2][3]);
          const float rs = __builtin_amdgcn_rsqf(wave_sum(ss) * (1.0f / 256.0f) + EPS);
          const f32x4 g = *(const f32x4*)(kvn + 4 * lane); const f32x4 o = v[2] * rs * g;
          *(v2u*)(CKV + (size_t)kr * 256 + 4 * lane) = pk4(o);
          if (!lat) *(f32x4*)(a.out + OUT_CKV + (size_t)m * 256 + 4 * lane) = o; }
        { const f32x4 x = v[3]; f32x4 xp;
#pragma unroll
          for (int i = 0; i < 4; ++i) xp[i] = __shfl_xor(x[i], 4);
          f32x4 o = x;
          if (lat) { const int l16 = lane & 15, half = l16 >> 3, part = (l16 & 7) >> 2, pos = half ? (t & 63) : (t >> 6);
              const f32x4 cs = *(const f32x4*)(ROPE + pos * 16 + 4 * (l16 & 3)), sn = *(const f32x4*)(ROPE + 1024 + pos * 16 + 4 * (l16 & 3));
              o = part == 0 ? x * cs - xp * sn : x * cs + xp * sn; }
          if (lane < 16) { *(v2u*)(KPE + (size_t)kr * 64 + 4 * lane) = pk4(o); if (!lat) *(f32x4*)(a.out + OUT_KPE + (size_t)m * 64 + 4 * lane) = o; } }
    }
}

#ifndef MK_ONE_LAUNCH
#define MK_ONE_LAUNCH 1
#endif
constexpr int N_PHASES = 2 + 9 * 4;
__host__ __device__ constexpr bool phase_used(int p) { if (p < 2) return true; const int l = (p - 2) / 9, s = (p - 2) % 9; if (s >= 4) return true; return (l == 2) ? true : (s < 2); }
#define PG8_ALIGN true
#define PG8_SP2 true


struct Ctx { LAS unsigned char* lds; unsigned char* ws; const float* MOD; const float* ROPE; float* xout; bf16* XN; float* Y; bf16* Hb; int G, bid, lo, hi; };
#define IN(k) (lo <= (k) && (k) < hi)
#if MK_ONE_LAUNCH
#define GRID_BAR() xcd_barrier(bar)
#else
#define GRID_BAR() do {} while (0)
#endif
#define SEAM(k) do { if (IN(k) && (k) + 1 < hi) GRID_BAR(); } while (0)
template <int L>
__device__ __forceinline__ void layer_body(const Args& args, const Ctx& cx, const XcdBarrier& bar) {
    LAS unsigned char* lds = cx.lds; unsigned char* ws = cx.ws; const float* MOD = cx.MOD; const float* ROPE = cx.ROPE; float* xout = cx.xout; bf16* XN = cx.XN; float* Y = cx.Y; bf16* Hb = cx.Hb;
    const int G = cx.G, bid = cx.bid, lo = cx.lo, hi = cx.hi;
    const int tid = (int)launder((unsigned)threadIdx.x), lane = tid & 63, wave = __builtin_amdgcn_readfirstlane(tid >> 6);
    {
        constexpr int l = L; constexpr int pb = 2 + 9 * l;
        const float* MODl = MOD + (size_t)l * 5 * MODW;
        const bf16* Omix = nullptr; const bf16* Wo = nullptr;
        if constexpr (l == 0) {
            Omix = (const bf16*)(ws + WS_A_O); Wo = (const bf16*)(ws + WS_A_WO);
            if (IN(pb + 0)) {
                pg8::Gemm g{XN, (const bf16*)(ws + WS_A_WQKV), NTOK, 6144, DM}; pg8::StaticOrder S; S.init(NTOK, 6144, G, bid);
                pg8::EpiQKV E{(bf16*)(ws + WS_A_Q), (bf16*)(ws + WS_A_KALL), (bf16*)(ws + WS_A_VALL), args.out + OUT_AK, args.out + OUT_AV, ROPE, 8, 8, DM, DM, 0.125f * LOG2E};
                pg8::gemm_phase<pg8::EpiQKV, pg8::StaticOrder, PG8_ALIGN, PG8_SP2>(lds + RING_OFF, g, S, E);
            } SEAM(pb + 0);
            if (IN(pb + 1)) {
#ifndef NO_ATTN_A
 attn_phase_A(args, lds, tid, wave, lane);
#endif
 } SEAM(pb + 1);
        } else if constexpr (l == 1) {
            Omix = (const bf16*)(ws + WS_B_O); Wo = (const bf16*)(ws + WS_B_WO);
            if (IN(pb + 0)) {
                { pg8::Gemm g{(const bf16*)(ws + WS_B_WP), XN, 8192, NTOK, DM}; pg8::StaticOrder S; S.init(8192, NTOK, G, bid);
                  pg8::EpiHgrnT E{(bf16*)(ws + WS_B_QT), (bf16*)(ws + WS_B_VT), (bf16*)(ws + WS_B_LF), (bf16*)(ws + WS_B_KK), (const float*)(ws + WS_LBT)};
                  pg8::gemm_phase<pg8::EpiHgrnT, pg8::StaticOrder, PG8_ALIGN, PG8_SP2>(lds + RING_OFF, g, S, E); }
                { pg8::Gemm g{XN, (const bf16*)(ws + WS_B_WG), NTOK, DM, DM}; pg8::StaticOrder S; S.init(NTOK, DM, G, bid);
                  pg8::EpiBf16<1> E{(bf16*)(ws + WS_B_G), DM, 0, 0};
                  pg8::gemm_phase<pg8::EpiBf16<1>, pg8::StaticOrder, PG8_ALIGN, PG8_SP2>(lds + RING_OFF, g, S, E); }
            } SEAM(pb + 0);
            if (IN(pb + 1)) {
#ifndef NO_SCAN
 scan_phase(args, lds, tid, wave, lane);
#endif
 } SEAM(pb + 1);
        } else if constexpr (l == 2) {
            Omix = (const bf16*)(ws + WS_C_O); Wo = (const bf16*)(ws + WS_C_WO);
            if (IN(pb + 0)) {
                pg8::Gemm g{XN, (const bf16*)(ws + WS_C_WD), NTOK, 1024, DM}; pg8::StaticOrder S; S.init(NTOK, 1024, G, bid);
                pg8::EpiF32 E{(float*)(ws + WS_C_QD), 1024};
                pg8::gemm_phase<pg8::EpiF32, pg8::StaticOrder, PG8_ALIGN, PG8_SP2>(lds + RING_OFF, g, S, E);
            } SEAM(pb + 0);
            if (IN(pb + 1)) { mla_thin_phase(args, wave, lane); } SEAM(pb + 1);
            if (IN(pb + 2)) {
                { int kq_ = 512; asm volatile("" : "+s"(kq_)); pg8::Gemm g{(const bf16*)(ws + WS_C_QDN), (const bf16*)(ws + WS_C_WUQ), NTOK, 3072, kq_}; pg8::StaticOrder S; S.init(NTOK, 3072, G, bid);
                  pg8::EpiMlaQ E{(bf16*)(ws + WS_C_Q), ROPE, 0.07216878364870322f * LOG2E};
                  pg8::gemm_phase<pg8::EpiMlaQ, pg8::StaticOrder, PG8_ALIGN, PG8_SP2>(lds + RING_OFF, g, S, E); }
                { int kk_ = 256; asm volatile("" : "+s"(kk_)); pg8::Gemm g{(const bf16*)(ws + WS_C_CKVALL), (const bf16*)(ws + WS_C_WUKV), NKEY, 4096, kk_}; pg8::StaticOrder S; S.init(NKEY, 4096, G, bid);
                  pg8::EpiBf16<0> E{(bf16*)(ws + WS_C_KN), DM, 2048, (size_t)(WS_C_VV - WS_C_KN) / 2};
                  pg8::gemm_phase<pg8::EpiBf16<0>, pg8::StaticOrder, PG8_ALIGN, PG8_SP2>(lds + RING_OFF, g, S, E); }
            } SEAM(pb + 2);
            if (IN(pb + 3)) {
#ifndef NO_ATTN_C
 attn_phase_C(args, lds, tid, wave, lane);
#endif
 } SEAM(pb + 3);
        } else {
            Omix = (const bf16*)(ws + WS_D_O); Wo = (const bf16*)(ws + WS_D_WO);
            if (IN(pb + 0)) {
                pg8::Gemm g{XN, (const bf16*)(ws + WS_D_WQKV), NTOK, 2560, DM}; pg8::StaticOrder S; S.init(NTOK, 2560, G, bid);
                pg8::EpiQKV E{(bf16*)(ws + WS_D_Q), (bf16*)(ws + WS_D_KALL), (bf16*)(ws + WS_D_VALL), args.out + OUT_DK, args.out + OUT_DV, ROPE, 8, 1, DM, 256, 0.125f * LOG2E};
                pg8::gemm_phase<pg8::EpiQKV, pg8::StaticOrder, PG8_ALIGN, PG8_SP2>(lds + RING_OFF, g, S, E);
            } SEAM(pb + 0);
            if (IN(pb + 1)) {
#ifndef NO_ATTN_D
 attn_phase_D(args, lds, tid, wave, lane);
#endif
 } SEAM(pb + 1);
        }
        if (IN(pb + 4)) {
            pg8::Gemm g{Omix, Wo, NTOK, DM, DM}; pg8::StaticOrder S; S.init(NTOK, DM, G, bid);
            pg8::EpiF32 E{Y, DM};
            pg8::gemm_phase<pg8::EpiF32, pg8::StaticOrder, PG8_ALIGN, PG8_SP2>(lds + RING_OFF, g, S, E);
        } SEAM(pb + 4);
        if (IN(pb + 5)) {
            const float* xp = l == 0 ? args.in[I_XP] : xout; const float* xs = l == 0 ? args.in[I_XS] : xout + (size_t)NCTX * DM;
            nr_phase<true, true>(xp, xs, xout, Y, MODl + 2 * DM, args.in[I_NMPOST] + l * DM, args.in[I_NFPRE] + l * DM, MODl + 3 * DM, MODl + 4 * DM, XN, wave, lane);
        } SEAM(pb + 5);
        if (IN(pb + 6)) {
            pg8::Gemm g{XN, (const bf16*)(ws + WS_F_WGU + (size_t)l * F_WGU_BYTES), NTOK, 2 * DFF, DM}; pg8::StaticOrder S; S.init(NTOK, 2 * DFF, G, bid);
            pg8::EpiSwiGLU E{Hb, DFF};
            pg8::gemm_phase<pg8::EpiSwiGLU, pg8::StaticOrder, PG8_ALIGN, PG8_SP2>(lds + RING_OFF, g, S, E);
        } SEAM(pb + 6);
        if (IN(pb + 7)) {
            pg8::Gemm g{Hb, (const bf16*)(ws + WS_F_WD + (size_t)l * F_WD_BYTES), NTOK, DM, DFF}; pg8::StaticOrder S; S.init(NTOK, DM, G, bid);
            pg8::EpiF32 E{Y, DM};
            pg8::gemm_phase<pg8::EpiF32, pg8::StaticOrder, PG8_ALIGN, PG8_SP2>(lds + RING_OFF, g, S, E);
        } SEAM(pb + 7);
        if (IN(pb + 8)) {
            const float* xs2 = xout + (size_t)NCTX * DM;
            if constexpr (l < 3) nr_phase<true, true>(xout, xs2, xout, Y, MODl + 5 * DM, args.in[I_NFPOST] + l * DM, args.in[I_NMPRE] + (l + 1) * DM, MODl + 5 * MODW + 0 * DM, MODl + 5 * MODW + 1 * DM, XN, wave, lane);
            else nr_phase<true, false>(xout, xs2, xout, Y, MODl + 5 * DM, args.in[I_NFPOST] + l * DM, nullptr, nullptr, nullptr, XN, wave, lane);
        }
        if constexpr (l < 3) SEAM(pb + 8);
    }

}
__global__ void __launch_bounds__(NTHR, 2) fwd(Args args) {
    extern __shared__ __attribute__((aligned(16))) unsigned char lds_raw[];
    LAS unsigned char* lds = (LAS unsigned char*)lds_raw;
    const int tid = threadIdx.x, lane = tid & 63, wave = __builtin_amdgcn_readfirstlane(tid >> 6);
    unsigned char* ws = args.ws;
    for (int u = tid; u < (LDS_BYTES - LDSCTL_OFF) / 4; u += NTHR) ((LAS unsigned*)(lds + LDSCTL_OFF))[u] = 0u;
    __syncthreads();
#if MK_ONE_LAUNCH
    XcdBarrier bar = xcd_barrier_post((unsigned*)(ws + WS_CTL) + CW_BAR, (volatile LAS unsigned*)(lds + MISC_OFF) + 8);
#else
    XcdBarrier bar; bar.bar = nullptr; bar.x = 0; bar.st = nullptr;
#endif
    const int lo = args.ph_lo, hi = args.ph_hi;
    const float* MOD = (const float*)(ws + WS_MOD);
    const float* ROPE = (const float*)(ws + WS_ROPE);
    float* xout = args.out + OUT_Y;
    bf16* XN = (bf16*)(ws + WS_XN);
    float* Y = (float*)(ws + WS_Y);
    bf16* Hb = (bf16*)(ws + WS_H);
    const int G = gridDim.x, bid = (int)blockIdx.x;

    if (IN(0)) { p0_prologue(args, lds, tid, wave, lane); } SEAM(0);
    if (IN(1)) { nr_phase<false, true>(args.in[I_XP], args.in[I_XS], nullptr, nullptr, nullptr, nullptr, args.in[I_NMPRE], MOD + 0 * DM, MOD + 1 * DM, XN, wave, lane); } SEAM(1);

    Ctx cx{lds, ws, MOD, ROPE, xout, XN, Y, Hb, G, bid, lo, hi};
    layer_body<0>(args, cx, bar); layer_body<1>(args, cx, bar); layer_body<2>(args, cx, bar); layer_body<3>(args, cx, bar);
#undef IN
#undef SEAM
}

extern "C" void kernel_launch(void* const* d_in, const int* in_sizes, int n_in, void* d_out, int out_size, void* d_ws, size_t ws_size, hipStream_t stream) {
    static int grid = 0;
    if (grid == 0) {
        if (n_in != N_IN || out_size != (int)OUT_END || ws_size < WS_END) { fprintf(stderr, "kernel_launch: unexpected shapes: n_in %d out %d ws %zu (need %zu)\n", n_in, out_size, ws_size, (size_t)WS_END); grid = -1; return; }
        int dev = 0, cus = 0, per_cu = 0;
        if (hipGetDevice(&dev) != hipSuccess || hipDeviceGetAttribute(&cus, hipDeviceAttributeMultiprocessorCount, dev) != hipSuccess) { grid = -1; return; }
        if (hipFuncSetAttribute((const void*)fwd, hipFuncAttributeMaxDynamicSharedMemorySize, LDS_BYTES) != hipSuccess) { fprintf(stderr, "kernel_launch: hipFuncSetAttribute failed\n"); grid = -1; return; }
        if (hipOccupancyMaxActiveBlocksPerMultiprocessor(&per_cu, (const void*)fwd, NTHR, LDS_BYTES) != hipSuccess || per_cu < 1) fprintf(stderr, "kernel_launch: occupancy query says %d\n", per_cu);
        (void)hipGetLastError();
        grid = cus;
    }
    if (grid < 0) return;
    (void)hipMemsetAsync((char*)d_ws + WS_CTL, 0, CTL_ZERO_BYTES, stream);
    Args a{};
    for (int i = 0; i < N_IN; ++i) a.in[i] = (const float*)d_in[i];
    a.out = (float*)d_out; a.ws = (unsigned char*)d_ws;
#if MK_ONE_LAUNCH
    a.ph_lo = 0; a.ph_hi = N_PHASES;
    hipLaunchKernelGGL(fwd, dim3(grid), dim3(NTHR), LDS_BYTES, stream, a);
#else
    for (int p = 0; p < N_PHASES; ++p) { if (!phase_used(p)) continue; a.ph_lo = p; a.ph_hi = p + 1; hipLaunchKernelGGL(fwd, dim3(grid), dim3(NTHR), LDS_BYTES, stream, a); }
#endif
}
```

```cpp
#include <hip/hip_runtime.h>
#include <cstdio>
#include <cstdint>
namespace pg8 {
#define PG8_LAS __attribute__((address_space(3)))
typedef unsigned short bf16_t;
typedef short bf16x8 __attribute__((ext_vector_type(8)));
typedef float f32x4 __attribute__((ext_vector_type(4)));
typedef unsigned u32x4 __attribute__((ext_vector_type(4)));
constexpr int BM = 256, BK = 64, HALF = 128, HTB = HALF * BK * 2  , STAGE_BYTES = 8 * HTB, NXCD = 8, WGM = 8;

__host__ __device__ __forceinline__ int lds_byte(int r, int c) { const int st = (r >> 4) * 2 + (c >> 5), rr = r & 15, cc = c & 31, ob = rr * 64 + cc * 2; return st * 1024 + (ob ^ (((ob >> 9) & 1) << 5)); }
__host__ __device__ __forceinline__ void stage_rc(int b, int& R, int& C) { const int st = b / 1024, sb = b % 1024, swz = sb ^ (((sb >> 9) & 1) << 5); R = (st >> 1) * 16 + swz / 64; C = (st & 1) * 32 + (swz % 64) / 2; }
__host__ __device__ __forceinline__ int perm32(int rho) { const int n = rho >> 4, i = rho & 15; return 8 * (i >> 2) + 4 * n + (i & 3); }

struct Unit { int pm, pn; };
struct Gemm { const bf16_t* A; const bf16_t* Bt; int M, N, K; };

struct StaticOrder {
    int nM, nN, nwg, G, c;
    __host__ __device__ void init(int M, int N, int G_, int c_) { nM = M / BM; nN = N / BM; nwg = nM * nN; G = G_; c = c_; }
    __host__ __device__ bool next(int i, Unit& u) const {
        const long L = (long)i * G + c; if (L >= nwg) return false;
        int wgid = (int)L; { const int q = nwg / NXCD, r = nwg % NXCD, xcd = wgid % NXCD, off = wgid / NXCD; wgid = (xcd < r ? xcd * (q + 1) : r * (q + 1) + (xcd - r) * q) + off; }
        const int nig = WGM * nN, gid = wgid / nig, fm = gid * WGM, gsz = (nM - fm) < WGM ? (nM - fm) : WGM;
        u.pm = fm + ((wgid % nig) % gsz); u.pn = (wgid % nig) / gsz; return true;
    }
    __device__ __forceinline__ void a_ready(const Unit&) const {}
    __device__ __forceinline__ void done(const Unit&) const {}
};


typedef float f32x2 __attribute__((ext_vector_type(2)));
typedef __bf16 bf16x2_t __attribute__((ext_vector_type(2)));
typedef unsigned u32x2 __attribute__((ext_vector_type(2)));
__device__ __forceinline__ unsigned cvt_pk_bf16(float lo, float hi) { f32x2 v = {lo, hi}; bf16x2_t b = __builtin_convertvector(v, bf16x2_t); return __builtin_bit_cast(unsigned, b); }
__device__ __forceinline__ u32x2 pk4(f32x4 v) { u32x2 w; w.x = cvt_pk_bf16(v[0], v[1]); w.y = cvt_pk_bf16(v[2], v[3]); return w; }
__device__ __forceinline__ u32x4 pk8(f32x4 a, f32x4 b) { u32x4 w; w.x = cvt_pk_bf16(a[0], a[1]); w.y = cvt_pk_bf16(a[2], a[3]); w.z = cvt_pk_bf16(b[0], b[1]); w.w = cvt_pk_bf16(b[2], b[3]); return w; }
__device__ __forceinline__ float fast_exp(float x) { return __builtin_amdgcn_exp2f(x * 1.4426950408889634f); }
__device__ __forceinline__ float sigmoidf_(float x) { return __builtin_amdgcn_rcpf(1.0f + fast_exp(-x)); }
__device__ __forceinline__ float siluf_(float x) { return x * sigmoidf_(x); }
__device__ __forceinline__ f32x4 silu4(f32x4 v) { return (f32x4){siluf_(v[0]), siluf_(v[1]), siluf_(v[2]), siluf_(v[3])}; }

__device__ __forceinline__ int keyrow_of_tile(int pm) { return pm < 16 ? pm * 256 : 4096 + ((pm - 16) >> 2) * 1280 + 256 + ((pm - 16) & 3) * 256; }

struct EpiF32 {
    static constexpr bool PERM = false, AFTER_DRAIN = false;
    float* O; int ldc;
    __device__ __forceinline__ void operator()(const f32x4 (&acc)[2][2][4][2], const Unit& u, int wr, int wc, int fr, int fq) const {
        const int row0 = u.pm * BM + wr * 64 + fr, col0 = u.pn * BM + wc * 32 + 4 * fq;
#pragma unroll
        for (int ai = 0; ai < 2; ++ai)
#pragma unroll
            for (int m = 0; m < 4; ++m) { float* rowp = O + (size_t)(row0 + ai * HALF + m * 16) * ldc + col0;
#pragma unroll
                for (int bj = 0; bj < 2; ++bj)
#pragma unroll
                    for (int n = 0; n < 2; ++n) *(f32x4*)(rowp + bj * HALF + n * 16) = acc[ai][bj][m][n]; }
    }
};

template <int ACT  > struct EpiBf16 {
    static constexpr bool PERM = true, AFTER_DRAIN = false;
    bf16_t* O; int ldc; int split_cols; size_t split_stride;
    __device__ __forceinline__ void operator()(const f32x4 (&acc)[2][2][4][2], const Unit& u, int wr, int wc, int fr, int fq) const {
        const int row0 = u.pm * BM + wr * 64 + fr; int colt = u.pn * BM; bf16_t* base = O;
        if (split_cols) { const int t = colt / split_cols; base += (size_t)t * split_stride; colt -= t * split_cols; }
        const int col0 = colt + wc * 32 + 8 * fq;
#pragma unroll
        for (int ai = 0; ai < 2; ++ai)
#pragma unroll
            for (int m = 0; m < 4; ++m) { bf16_t* rowp = base + (size_t)(row0 + ai * HALF + m * 16) * ldc + col0;
#pragma unroll
                for (int bj = 0; bj < 2; ++bj) { f32x4 v0 = acc[ai][bj][m][0], v1 = acc[ai][bj][m][1];
                    if (ACT == 1) { v0 = silu4(v0); v1 = silu4(v1); }
                    *(u32x4*)(rowp + bj * HALF) = pk8(v0, v1); } }
    }
};

struct EpiSwiGLU {
    static constexpr bool PERM = true, AFTER_DRAIN = false;
    bf16_t* H; int ldc;
    __device__ __forceinline__ void operator()(const f32x4 (&acc)[2][2][4][2], const Unit& u, int wr, int wc, int fr, int fq) const {
        const int row0 = u.pm * BM + wr * 64 + fr, col0 = u.pn * HALF + wc * 32 + 8 * fq;
#pragma unroll
        for (int ai = 0; ai < 2; ++ai)
#pragma unroll
            for (int m = 0; m < 4; ++m) { bf16_t* rowp = H + (size_t)(row0 + ai * HALF + m * 16) * ldc + col0;
                const f32x4 v0 = silu4(acc[ai][0][m][0]) * acc[ai][1][m][0], v1 = silu4(acc[ai][0][m][1]) * acc[ai][1][m][1];
                *(u32x4*)rowp = pk8(v0, v1); }
    }
};

struct EpiQKV {
    static constexpr bool PERM = false, AFTER_DRAIN = false;
    bf16_t* Q; bf16_t* KALL; bf16_t* VALL; float* outk; float* outv; const float* rope; int nqt, nkt, ldq, ldk; float qscale;
    __device__ __forceinline__ void operator()(const f32x4 (&acc)[2][2][4][2], const Unit& u, int wr, int wc, int fr, int fq) const {
        const int which = u.pn < nqt ? 0 : (u.pn < nqt + nkt ? 1 : 2);
        const int colt = (which == 0 ? u.pn : which == 1 ? u.pn - nqt : u.pn - nqt - nkt) * BM + wc * 32 + 4 * fq;
        const bool lat = u.pm >= 16;
        const int krow0 = keyrow_of_tile(u.pm);
#pragma unroll
        for (int ai = 0; ai < 2; ++ai)
#pragma unroll
            for (int m = 0; m < 4; ++m) {
                const int rl = ai * HALF + wr * 64 + m * 16 + fr, row = u.pm * BM + rl;
                f32x4 cs = (f32x4){1.f, 1.f, 1.f, 1.f}, sn = (f32x4){0.f, 0.f, 0.f, 0.f};
                if (lat && which < 2) { const int tl = (row - 4096) & 1023, pos = (wc & 1) ? (tl & 63) : (tl >> 6);
                    cs = *(const f32x4*)(rope + pos * 16 + 4 * fq); sn = *(const f32x4*)(rope + 1024 + pos * 16 + 4 * fq); }
#pragma unroll
                for (int bj = 0; bj < 2; ++bj) {
                    const f32x4 x1 = acc[ai][bj][m][0], x2 = acc[ai][bj][m][1];
                    f32x4 o1 = x1, o2 = x2;
                    if (which < 2) { o1 = x1 * cs - x2 * sn; o2 = x2 * cs + x1 * sn; }
                    const int col = colt + bj * HALF;
                    if (which == 0) { o1 = o1 * qscale; o2 = o2 * qscale; bf16_t* p = Q + (size_t)row * ldq + col; *(u32x2*)p = pk4(o1); *(u32x2*)(p + 16) = pk4(o2); }
                    else { bf16_t* p = (which == 1 ? KALL : VALL) + (size_t)(krow0 + rl) * ldk + col; *(u32x2*)p = pk4(o1); *(u32x2*)(p + 16) = pk4(o2);
                        if (!lat) { float* f = (which == 1 ? outk : outv) + (size_t)row * ldk + col; *(f32x4*)f = o1; *(f32x4*)(f + 16) = o2; } }
                }
            }
    }
};

struct EpiMlaQ {
    static constexpr bool PERM = false, AFTER_DRAIN = false;
    bf16_t* Q; const float* rope; float qscale;
    __device__ __forceinline__ void operator()(const f32x4 (&acc)[2][2][4][2], const Unit& u, int wr, int wc, int fr, int fq) const {
        const bool lat = u.pm >= 16;
#pragma unroll
        for (int ai = 0; ai < 2; ++ai)
#pragma unroll
            for (int m = 0; m < 4; ++m) {
                const int row = u.pm * BM + ai * HALF + wr * 64 + m * 16 + fr; const int tl = (row - 4096) & 1023;
#pragma unroll
                for (int bj = 0; bj < 2; ++bj) {
                    const int G = u.pn * 8 + bj * 4 + wc, gm = G % 6;
                    const f32x4 x1 = acc[ai][bj][m][0], x2 = acc[ai][bj][m][1];
                    f32x4 o1 = x1, o2 = x2;
                    if (lat && gm >= 4) { const int pos = (gm == 5) ? (tl & 63) : (tl >> 6);
                        const f32x4 cs = *(const f32x4*)(rope + pos * 16 + 4 * fq), sn = *(const f32x4*)(rope + 1024 + pos * 16 + 4 * fq);
                        o1 = x1 * cs - x2 * sn; o2 = x2 * cs + x1 * sn; }
                    o1 = o1 * qscale; o2 = o2 * qscale;
                    bf16_t* p = Q + (size_t)row * 3072 + G * 32 + 4 * fq; *(u32x2*)p = pk4(o1); *(u32x2*)(p + 16) = pk4(o2);
                }
            }
    }
};

struct EpiHgrnT {
    static constexpr bool PERM = true, AFTER_DRAIN = false;
    bf16_t* QT; bf16_t* VT; bf16_t* LF; bf16_t* KK; const float* lb;
    __device__ __forceinline__ void operator()(const f32x4 (&acc)[2][2][4][2], const Unit& u, int wr, int wc, int fr, int fq) const {
        const int which = u.pm >> 3;
        const int ch0 = (u.pm & 7) * BM + wr * 64 + fr, col0 = u.pn * BM + wc * 32 + 8 * fq;
#pragma unroll
        for (int ai = 0; ai < 2; ++ai)
#pragma unroll
            for (int m = 0; m < 4; ++m) { const int ch = ch0 + ai * HALF + m * 16;
                float lbv = 0.f; if (which >= 2) lbv = lb[(which - 2) * 2048 + ch];
#pragma unroll
                for (int bj = 0; bj < 2; ++bj) { f32x4 v0 = acc[ai][bj][m][0], v1 = acc[ai][bj][m][1];
                    const int tok = col0 + bj * HALF;
                    const size_t off = ((size_t)((ch >> 7) * 256 + (tok >> 5)) * 128 + (ch & 127)) * 32 + (tok & 31);
                    if (which == 0) { *(u32x4*)(QT + off) = pk8(silu4(v0), silu4(v1)); }
                    else if (which == 1) { *(u32x4*)(VT + off) = pk8(v0, v1); }
                    else { f32x4 l0, l1, k0, k1;
#pragma unroll
                        for (int e = 0; e < 4; ++e) { const float f0 = lbv + (1.f - lbv) * sigmoidf_(v0[e]), f1 = lbv + (1.f - lbv) * sigmoidf_(v1[e]);
                            l0[e] = __builtin_amdgcn_logf(f0) * 0.6931471805599453f; l1[e] = __builtin_amdgcn_logf(f1) * 0.6931471805599453f; k0[e] = 1.f - f0; k1[e] = 1.f - f1; }
                        const size_t o2 = (size_t)(which - 2) * 2048 * 8192 + off;
                        *(u32x4*)(LF + o2) = pk8(l0, l1); *(u32x4*)(KK + o2) = pk8(k0, k1); } } }
    }
};
template <class Epi, class Sched, bool ALIGN_EPI = false, bool SP2 = false>
__device__ __forceinline__ void gemm_phase(PG8_LAS unsigned char* lds, const Gemm g, const Sched& S, const Epi& E) {
    const int tid = threadIdx.x, wid = __builtin_amdgcn_readfirstlane(tid >> 6), lane = tid & 63, wr = wid >> 2, wc = wid & 3, fr = lane & 15, fq = lane >> 4;
    const int K = g.K, nt = K / BK;
    unsigned voffA[2], voffB[2];
#pragma unroll
    for (int i = 0; i < 2; ++i) { int R, C; stage_rc(tid * 16 + i * 8192, R, C); const int Rb = Epi::PERM ? ((R & ~31) + perm32(R & 31)) : R;
        voffA[i] = (unsigned)(R * K + C) * 2u; voffB[i] = (unsigned)(Rb * K + C) * 2u; }
    const size_t kstep = (size_t)(BK * 2);
    const size_t hstep = (size_t)HALF * K * 2;
    const size_t tstep = 2 * hstep;
    const unsigned ldsw = (unsigned)wid * 1024u;
    const int aoff = lds_byte(wr * 64 + fr, fq * 8), boff = lds_byte(wc * 32 + fr, fq * 8);
#define PG8_SA(b, h) (((b) * 2 + (h)) * HTB)
#define PG8_SB(b, h) ((4 + (b) * 2 + (h)) * HTB)
#define PG8_STAGE(bufoff, gbase, voff) do { _Pragma("unroll") for (int _i = 0; _i < 2; ++_i) \
        __builtin_amdgcn_global_load_lds((const unsigned*)((const char*)(gbase) + (voff)[_i]), (PG8_LAS unsigned*)(lds + (bufoff) + ldsw + _i * 8192), 16, 0, 0); } while (0)
#define PG8_LDA(dst, b, h) do { _Pragma("unroll") for (int m = 0; m < 4; ++m) _Pragma("unroll") for (int k = 0; k < 2; ++k) dst[m][k] = *(const PG8_LAS bf16x8*)(lds + PG8_SA(b, h) + aoff + m * 2048 + k * 1024); } while (0)
#define PG8_LDB(dst, b, h) do { _Pragma("unroll") for (int n = 0; n < 2; ++n) _Pragma("unroll") for (int k = 0; k < 2; ++k) dst[n][k] = *(const PG8_LAS bf16x8*)(lds + PG8_SB(b, h) + boff + n * 2048 + k * 1024); } while (0)
#define PG8_MMA(ai, bj, At, Bt) do { __builtin_amdgcn_s_setprio(1); _Pragma("unroll") for (int m = 0; m < 4; ++m) _Pragma("unroll") for (int n = 0; n < 2; ++n) _Pragma("unroll") for (int k = 0; k < 2; ++k) \
        acc[ai][bj][m][n] = __builtin_amdgcn_mfma_f32_16x16x32_bf16(Bt[n][k], At[m][k], acc[ai][bj][m][n], 0, 0, 0); __builtin_amdgcn_s_setprio(0); } while (0)
#define PG8_WAIT_V(n) asm volatile("s_waitcnt vmcnt(" #n ")" ::: "memory")
#define PG8_WAIT_L(n) asm volatile("s_waitcnt lgkmcnt(" #n ")" ::: "memory")
#define PG8_BAR __builtin_amdgcn_s_barrier()
#define PG8_SCHED __builtin_amdgcn_sched_barrier(0)
    Unit cur, nxt; int ui = 0;
    if (!S.next(0, cur)) return;
    f32x4 acc[2][2][4][2];
#pragma unroll
    for (int a = 0; a < 2; ++a)
#pragma unroll
        for (int b = 0; b < 2; ++b)
#pragma unroll
            for (int m = 0; m < 4; ++m)
#pragma unroll
                for (int n = 0; n < 2; ++n) acc[a][b][m][n] = (f32x4){0.f, 0.f, 0.f, 0.f};
    bf16x8 At[4][2], B0[2][2], B1[2][2];
    const char* cA = (const char*)g.A + (size_t)cur.pm * tstep; const char* cB = (const char*)g.Bt + (size_t)cur.pn * tstep;
    S.a_ready(cur);
    if constexpr (SP2) {
        PG8_STAGE(PG8_SB(0, 0), cB, voffB); PG8_STAGE(PG8_SB(0, 1), cB + hstep, voffB); PG8_STAGE(PG8_SA(0, 0), cA, voffA); PG8_STAGE(PG8_SA(0, 1), cA + hstep, voffA);
        if (wr == 1) PG8_BAR;
        PG8_WAIT_V(2); PG8_BAR;
        PG8_STAGE(PG8_SB(1, 0), cB + kstep, voffB); PG8_STAGE(PG8_SA(1, 0), cA + kstep, voffA); PG8_STAGE(PG8_SB(1, 1), cB + hstep + kstep, voffB);
        PG8_WAIT_V(6); PG8_BAR;
    } else {
        PG8_STAGE(PG8_SB(0, 0), cB, voffB); PG8_STAGE(PG8_SA(0, 0), cA, voffA); PG8_STAGE(PG8_SB(0, 1), cB + hstep, voffB); PG8_STAGE(PG8_SA(0, 1), cA + hstep, voffA);
        if (wr == 1) PG8_BAR;
        PG8_WAIT_V(4); PG8_BAR;
        PG8_STAGE(PG8_SB(1, 0), cB + kstep, voffB); PG8_STAGE(PG8_SA(1, 0), cA + kstep, voffA); PG8_STAGE(PG8_SB(1, 1), cB + hstep + kstep, voffB);
        PG8_WAIT_V(6); PG8_BAR;
    }
    for (;;) {
        const bool has_next = S.next(ui + 1, nxt);
        const char* nA = has_next ? (const char*)g.A + (size_t)nxt.pm * tstep : cA; const char* nB = has_next ? (const char*)g.Bt + (size_t)nxt.pn * tstep : cB;
        for (int t = 0; t < nt; t += 2) {
            const bool last = (t == nt - 2);
            const char* a1 = cA + (size_t)(t + 1) * kstep;
            const char* a2 = last ? nA : cA + (size_t)(t + 2) * kstep; const char* b2 = last ? nB : cB + (size_t)(t + 2) * kstep;
            const char* a3 = a2 + kstep; const char* b3 = b2 + kstep;
            if (last && has_next) S.a_ready(nxt);
            if constexpr (SP2) {
            PG8_LDB(B0, 0, 0); PG8_LDB(B1, 0, 1); PG8_SCHED; PG8_LDA(At, 0, 0); PG8_STAGE(PG8_SA(1, 1), a1 + hstep, voffA);
            PG8_WAIT_V(8); PG8_WAIT_L(0); PG8_BAR; PG8_MMA(0, 0, At, B0); PG8_MMA(0, 1, At, B1); PG8_BAR; PG8_SCHED;
            PG8_LDA(At, 0, 1); PG8_STAGE(PG8_SB(0, 0), b2, voffB); PG8_STAGE(PG8_SB(0, 1), b2 + hstep, voffB); PG8_STAGE(PG8_SA(0, 0), a2, voffA);
            PG8_WAIT_V(8); PG8_WAIT_L(0); PG8_BAR; PG8_MMA(1, 0, At, B0); PG8_MMA(1, 1, At, B1); PG8_BAR; PG8_SCHED;
            PG8_LDB(B0, 1, 0); PG8_LDB(B1, 1, 1); PG8_SCHED; PG8_LDA(At, 1, 0); PG8_STAGE(PG8_SA(0, 1), a2 + hstep, voffA);
            PG8_WAIT_V(8); PG8_WAIT_L(0); PG8_BAR; PG8_MMA(0, 0, At, B0); PG8_MMA(0, 1, At, B1); PG8_BAR; PG8_SCHED;
            PG8_LDA(At, 1, 1); PG8_STAGE(PG8_SB(1, 0), b3, voffB); PG8_STAGE(PG8_SB(1, 1), b3 + hstep, voffB); PG8_STAGE(PG8_SA(1, 0), a3, voffA);
            PG8_WAIT_V(8); PG8_WAIT_L(0); PG8_BAR; PG8_MMA(1, 0, At, B0); PG8_MMA(1, 1, At, B1); PG8_BAR; PG8_SCHED;
            } else {
            PG8_LDB(B0, 0, 0); PG8_SCHED; PG8_LDA(At, 0, 0); PG8_STAGE(PG8_SA(1, 1), a1 + hstep, voffA);
            PG8_WAIT_L(8); PG8_BAR; PG8_WAIT_L(0); PG8_MMA(0, 0, At, B0); PG8_BAR; PG8_SCHED;
            PG8_LDB(B1, 0, 1); PG8_STAGE(PG8_SB(0, 0), b2, voffB);
            PG8_BAR; PG8_WAIT_L(0); PG8_MMA(0, 1, At, B1); PG8_BAR;
            PG8_LDA(At, 0, 1); PG8_STAGE(PG8_SA(0, 0), a2, voffA);
            PG8_BAR; PG8_WAIT_L(0); PG8_MMA(1, 0, At, B0); PG8_BAR; PG8_SCHED;
            PG8_STAGE(PG8_SB(0, 1), b2 + hstep, voffB);
            PG8_WAIT_V(6); PG8_BAR; PG8_MMA(1, 1, At, B1); PG8_BAR;
            PG8_LDB(B0, 1, 0); PG8_SCHED; PG8_LDA(At, 1, 0); PG8_STAGE(PG8_SA(0, 1), a2 + hstep, voffA);
            PG8_WAIT_L(8); PG8_BAR; PG8_WAIT_L(0); PG8_MMA(0, 0, At, B0); PG8_BAR; PG8_SCHED;
            PG8_LDB(B1, 1, 1); PG8_STAGE(PG8_SB(1, 0), b3, voffB);
            PG8_BAR; PG8_WAIT_L(0); PG8_MMA(0, 1, At, B1); PG8_BAR;
            PG8_LDA(At, 1, 1); PG8_STAGE(PG8_SA(1, 0), a3, voffA);
            PG8_BAR; PG8_WAIT_L(0); PG8_MMA(1, 0, At, B0); PG8_BAR; PG8_SCHED;
            PG8_STAGE(PG8_SB(1, 1), b3 + hstep, voffB);
            PG8_WAIT_V(6); PG8_BAR; PG8_MMA(1, 1, At, B1); PG8_BAR;
            }
        }
        if constexpr (ALIGN_EPI) { if (wr == 0) PG8_BAR; }
        if constexpr (!Epi::AFTER_DRAIN) { E(acc, cur, wr, wc, fr, fq); S.done(cur); }
        if (!has_next) break;
#pragma unroll
        for (int a = 0; a < 2; ++a)
#pragma unroll
            for (int b = 0; b < 2; ++b)
#pragma unroll
                for (int m = 0; m < 4; ++m)
#pragma unroll
                    for (int n = 0; n < 2; ++n) acc[a][b][m][n] = (f32x4){0.f, 0.f, 0.f, 0.f};
        cur = nxt; cA = nA; cB = nB; ++ui;
        if constexpr (ALIGN_EPI) { if (wr == 1) PG8_BAR; }
    }
    PG8_WAIT_V(0);
    if constexpr (!ALIGN_EPI) { if (wr == 0) PG8_BAR; }
    PG8_BAR;
    if constexpr (Epi::AFTER_DRAIN) { E.fused(acc, cur, wr, wc, fr, fq, lds, wid, lane); S.done(cur); }
#undef PG8_SA
#undef PG8_SB
#undef PG8_STAGE
#undef PG8_LDA
#undef PG8_LDB
#undef PG8_MMA
#undef PG8_WAIT_V
#undef PG8_WAIT_L
#undef PG8_BAR
#undef PG8_SCHED
}
}
#define LAS __attribute__((address_space(3)))
#define XB_TMO      128
#define XB_XCNT(j)  (256  + 64 * (j))
#define XB_XSUB(j)  (1280 + 64 * (j))
#define XB_XGEN(j)  (2304 + 64 * (j))
#define XB_TOP      3328
#define XB_TOPGEN   3392
#define XCD_BAR_WORDS 3456
#define XB_SPIN_CAP (1u << 18)

__device__ __forceinline__ unsigned xb_ld(unsigned* p)              { return __hip_atomic_load(p, __ATOMIC_RELAXED, __HIP_MEMORY_SCOPE_AGENT); }
__device__ __forceinline__ unsigned xb_add(unsigned* p, unsigned v) { return __hip_atomic_fetch_add(p, v, __ATOMIC_RELAXED, __HIP_MEMORY_SCOPE_AGENT); }
__device__ __forceinline__ unsigned xb_xcc_id() { return (unsigned)__builtin_amdgcn_s_getreg((3 << 11) | 20) & 0xFu; }
#define XB_SPIN(cond, bar) do { unsigned _sp = 0; while (cond) { __builtin_amdgcn_s_sleep(1); \
    if ((++_sp & 255u) == 0u) { if (xb_ld(&(bar)[XB_TMO])) break; if (_sp > XB_SPIN_CAP) { atomicAdd(&(bar)[XB_TMO], 1u); break; } } } } while (0)

struct XcdBarrier {
    unsigned* bar; unsigned x;
    volatile LAS unsigned* st;
};

__device__ __forceinline__ XcdBarrier xcd_barrier_post(unsigned* bar, volatile LAS unsigned* st) {
    XcdBarrier b; b.bar = bar; b.x = xb_xcc_id(); b.st = st;
    if (threadIdx.x == 0) (void)xb_add(&bar[XB_XCNT(b.x)], 1u);
    return b;
}
__device__ __forceinline__ void xcd_barrier_complete(unsigned* bar, unsigned x, unsigned& nloc, unsigned& nx) {
    const unsigned G = gridDim.x * gridDim.y * gridDim.z;
    unsigned sum, cnt, mine, sp = 0u;
    for (;;) {
        sum = 0u; cnt = 0u; mine = 0u;
#pragma unroll
        for (unsigned j = 0; j < 16; ++j) { const unsigned c = xb_ld(&bar[XB_XCNT(j)]); sum += c; cnt += (c > 0u) ? 1u : 0u; mine = (j == x) ? c : mine; }
        if (sum == G) break;
        __builtin_amdgcn_s_sleep(1);
        if ((++sp & 255u) == 0u) { if (xb_ld(&bar[XB_TMO])) break; if (sp > XB_SPIN_CAP) { atomicAdd(&bar[XB_TMO], 1u); break; } }
    }
    nloc = mine > 0u ? mine : 1u; nx = cnt > 0u ? cnt : 1u;
}

__device__ __forceinline__ void xcd_barrier(const XcdBarrier& b) {
    asm volatile("s_waitcnt vmcnt(0)" ::: "memory");
    __syncthreads();
    if (threadIdx.x == 0) {
        unsigned* bar = b.bar;
        __builtin_amdgcn_s_waitcnt(0);
        unsigned nloc = b.st[0], nx = b.st[1];
        if (nloc == 0u) { xcd_barrier_complete(bar, b.x, nloc, nx); b.st[0] = nloc; b.st[1] = nx; }
        const unsigned old = xb_add(&bar[XB_XSUB(b.x)], 1u);
        const unsigned gen = old / nloc;
        if (old + 1u == (gen + 1u) * nloc) {
            __builtin_amdgcn_fence(__ATOMIC_RELEASE, "agent");
            asm volatile("s_waitcnt vmcnt(0)" ::: "memory");
            const unsigned og = xb_add(&bar[XB_TOP], 1u);
            const unsigned tg = og / nx;
            if (og + 1u == (tg + 1u) * nx) xb_add(&bar[XB_TOPGEN], 1u);
            else XB_SPIN(xb_ld(&bar[XB_TOPGEN]) == tg, bar);
            __builtin_amdgcn_fence(__ATOMIC_ACQUIRE, "agent");
            xb_add(&bar[XB_XGEN(b.x)], 1u);
            asm volatile("s_waitcnt vmcnt(0)" ::: "memory");
        } else {
            XB_SPIN(xb_ld(&bar[XB_XGEN(b.x)]) == gen, bar);
            __builtin_amdgcn_fence(__ATOMIC_ACQUIRE, "agent");
            asm volatile("s_waitcnt vmcnt(0)" ::: "memory");
        }
    }
    __syncthreads();
}

constexpr int NWAVES = 8, NTHR = 512;
constexpr int DM = 2048, NTOK = 8192, NCTX = 4096, NKEY = 9216, DFF = 5632, MODW = 12288;
constexpr float EPS = 1e-6f, LOG2E = 1.4426950408889634f;
constexpr size_t OUT_Y = 0, OUT_AK = 16777216, OUT_AV = 25165824, OUT_BF = 33554432, OUT_BB = 37748736, OUT_CKV = 41943040, OUT_KPE = 42991616, OUT_DK = 43253760, OUT_DV = 44302336, OUT_END = 45350912;
enum { I_XP = 0, I_XS, I_CAK, I_CAV, I_SBF, I_SBB, I_CCKV, I_CKPE, I_CDK, I_CDV, I_C, I_CCTX, I_ADAW, I_ADAB, I_NMPRE, I_NMPOST, I_NFPRE, I_NFPOST,
       I_AWQ, I_AWK, I_AWV, I_AWO, I_ALAM, I_ASUBLN, I_BWQ, I_BWI, I_BWF, I_BLOWER, I_BWG, I_BGNORM, I_BWO,
       I_CWDQ, I_CQNORM, I_CWUQ, I_CWDKV, I_CKVNORM, I_CWUK, I_CWUV, I_CWO, I_DWQ, I_DWK, I_DWV, I_DSINK, I_DWO, I_FWG, I_FWU, I_FWD, N_IN };

constexpr size_t MiB = 1u << 20;
constexpr size_t WS_CTL = 0, CTL_ZERO_BYTES = 1 * MiB;
constexpr size_t WS_MOD = 1 * MiB;
constexpr size_t WS_ROPE = 2 * MiB;
constexpr size_t WS_LBT = 2 * MiB + 16384;
constexpr size_t WS_A_WQKV = 4 * MiB;
constexpr size_t WS_A_WO = WS_A_WQKV + 24 * MiB;
constexpr size_t WS_B_WP = WS_A_WO + 8 * MiB;
constexpr size_t WS_B_WG = WS_B_WP + 32 * MiB;
constexpr size_t WS_B_WO = WS_B_WG + 8 * MiB;
constexpr size_t WS_C_WD = WS_B_WO + 8 * MiB;
constexpr size_t WS_C_WUQ = WS_C_WD + 4 * MiB;
constexpr size_t WS_C_WUKV = WS_C_WUQ + 3 * MiB;
constexpr size_t WS_C_WO = WS_C_WUKV + 2 * MiB;
constexpr size_t WS_D_WQKV = WS_C_WO + 8 * MiB;
constexpr size_t WS_D_WO = WS_D_WQKV + 10 * MiB;
constexpr size_t WS_F_WGU = WS_D_WO + 8 * MiB;
constexpr size_t F_WGU_BYTES = 44 * MiB;
constexpr size_t WS_F_WD = WS_F_WGU + 4 * F_WGU_BYTES;
constexpr size_t F_WD_BYTES = 22 * MiB;
constexpr size_t WS_XN = WS_F_WD + 4 * F_WD_BYTES;
constexpr size_t WS_Y = WS_XN + 32 * MiB;
constexpr size_t WS_H = WS_Y + 64 * MiB;
constexpr size_t WS_A_KALL = WS_H + 88 * MiB;
constexpr size_t WS_A_VALL = WS_A_KALL + 36 * MiB;
constexpr size_t WS_C_CKVALL = WS_A_VALL + 36 * MiB;
constexpr size_t WS_C_KPEALL = WS_C_CKVALL + 5 * MiB;
constexpr size_t WS_D_KALL = WS_C_KPEALL + 2 * MiB;
constexpr size_t WS_D_VALL = WS_D_KALL + 5 * MiB;
constexpr size_t WS_MIX = WS_D_VALL + 5 * MiB;
constexpr size_t WS_A_Q = WS_MIX, WS_A_O = WS_MIX + 32 * MiB;
constexpr size_t WS_B_QT = WS_MIX, WS_B_VT = WS_MIX + 32 * MiB, WS_B_LF = WS_MIX + 64 * MiB, WS_B_KK = WS_MIX + 128 * MiB, WS_B_G = WS_MIX + 192 * MiB, WS_B_OT = WS_MIX + 224 * MiB, WS_B_O = WS_MIX + 352 * MiB;
constexpr size_t WS_C_QD = WS_MIX, WS_C_QDN = WS_MIX + 32 * MiB, WS_C_Q = WS_MIX + 40 * MiB, WS_C_KN = WS_MIX + 88 * MiB, WS_C_VV = WS_MIX + 124 * MiB, WS_C_O = WS_MIX + 160 * MiB;
constexpr size_t WS_D_Q = WS_MIX, WS_D_O = WS_MIX + 32 * MiB;
constexpr size_t WS_END = WS_MIX + 384 * MiB;
constexpr int CW_TMO = 0, CW_CODE = 1, CW_BAR = 4096;

constexpr int RING_OFF = 0, RING_BYTES = 131072;
constexpr int LDSCTL_OFF = RING_BYTES, MISC_OFF = LDSCTL_OFF + 320;
constexpr int LDS_BYTES = 147456;

#define GAS __attribute__((address_space(1)))
typedef unsigned short bf16;
typedef unsigned v4u __attribute__((ext_vector_type(4)));
typedef unsigned v2u __attribute__((ext_vector_type(2)));
typedef float f32x4 __attribute__((ext_vector_type(4)));
typedef float f32x16 __attribute__((ext_vector_type(16)));
typedef short bf16x8 __attribute__((ext_vector_type(8)));
typedef short s16x4 __attribute__((ext_vector_type(4)));
typedef GAS unsigned gu32;
#define RLX_AGENT __ATOMIC_RELAXED, __HIP_MEMORY_SCOPE_AGENT
using pg8::cvt_pk_bf16; using pg8::pk4; using pg8::pk8; using pg8::fast_exp; using pg8::siluf_; using pg8::sigmoidf_;
__device__ __forceinline__ float bf2f(unsigned short b) { return __uint_as_float((unsigned)b << 16); }
__device__ __forceinline__ float bflo(unsigned w) { return __uint_as_float(w << 16); }
__device__ __forceinline__ float bfhi(unsigned w) { return __uint_as_float(w & 0xffff0000u); }
__device__ __forceinline__ float wave_sum(float v) {
#pragma unroll
    for (int o = 1; o < 64; o <<= 1) v += __shfl_xor(v, o);
    return v;
}

struct Args { const float* in[N_IN]; float* out; unsigned char* ws; int ph_lo, ph_hi; };

__device__ __forceinline__ void p0_ada(const Args& a, LAS unsigned char* lds, int tid, int wave, int lane) {
    LAS float* sv = (LAS float*)lds;
    LAS float* red = (LAS float*)(lds + 40960);
    const float* c = a.in[I_C]; const float* cctx = a.in[I_CCTX];
    for (int i = tid; i < 5 * DM; i += NTHR) { const int r = i / DM, k = i % DM; const float v = r == 0 ? cctx[k] : c[(r - 1) * DM + k]; sv[i] = siluf_(v); }
    __syncthreads();
    float* MOD = (float*)(a.ws + WS_MOD);
    for (int item = blockIdx.x; item < 256; item += gridDim.x) {
        const int layer = item >> 6, cg = item & 63, k0 = 256 * wave; const bool active = lane < 48;
        const float* wp = a.in[I_ADAW] + ((size_t)layer * DM + k0) * MODW + 192 * cg + 4 * lane;
        f32x4 acc[5];
#pragma unroll
        for (int r = 0; r < 5; ++r) acc[r] = (f32x4){0.f, 0.f, 0.f, 0.f};
        if (active) {
            for (int kk = 0; kk < 256; kk += 8) {
                f32x4 wv[8];
#pragma unroll
                for (int u = 0; u < 8; ++u) wv[u] = __builtin_nontemporal_load((const f32x4*)(wp + (size_t)(kk + u) * MODW));
#pragma unroll
                for (int u = 0; u < 8; ++u)
#pragma unroll
                    for (int r = 0; r < 5; ++r) acc[r] += sv[r * DM + k0 + kk + u] * wv[u];
            }
#pragma unroll
            for (int r = 0; r < 5; ++r) *(LAS f32x4*)(red + (wave * 5 + r) * 192 + 4 * lane) = acc[r];
        }
        __syncthreads();
        for (int o = tid; o < 960; o += NTHR) { const int r = o / 192, cc = o % 192; float s = a.in[I_ADAB][layer * MODW + 192 * cg + cc];
#pragma unroll
            for (int w = 0; w < 8; ++w) s += red[(w * 5 + r) * 192 + cc];
            MOD[(size_t)(layer * 5 + r) * MODW + 192 * cg + cc] = s; }
        __syncthreads();
    }
}
__device__ __forceinline__ void transpose_item(const float* W, int N, bf16* WT, int ldt, int orow0, LAS float* scr, int k0, int n0, int lane) {
#pragma unroll 8
    for (int i = 0; i < 32; ++i) { const int kk = 2 * i + (lane >> 5); scr[kk * 33 + (lane & 31)] = __builtin_nontemporal_load(W + (size_t)(k0 + kk) * N + n0 + (lane & 31)); }
    asm volatile("s_waitcnt lgkmcnt(0)" ::: "memory");
    const int c = lane & 7;
#pragma unroll
    for (int j = 0; j < 4; ++j) { const int n = (lane >> 3) + 8 * j; const LAS float* s = scr + (8 * c) * 33 + n;
        v4u o; o.x = cvt_pk_bf16(s[0 * 33], s[1 * 33]); o.y = cvt_pk_bf16(s[2 * 33], s[3 * 33]); o.z = cvt_pk_bf16(s[4 * 33], s[5 * 33]); o.w = cvt_pk_bf16(s[6 * 33], s[7 * 33]);
        *(GAS v4u*)(WT + (size_t)(orow0 + n) * ldt + k0 + 8 * c) = o; }
    asm volatile("s_waitcnt lgkmcnt(0)" ::: "memory");
}
__device__ __forceinline__ void cvt_cache(const float* src, int W, bf16* dst, int gtid, int gthreads) {
    const int n4 = 4 * 256 * W / 4;
    for (int i = gtid; i < n4; i += gthreads) { const int e = 4 * i, b = e / (256 * W), rem = e % (256 * W), t = rem / W, cc = rem % W;
        const f32x4 v = *(const f32x4*)(src + e); *(v2u*)(dst + (size_t)(4096 + 1280 * b + t) * W + cc) = pk4(v); }
}
__device__ __forceinline__ void p0_prologue(const Args& a, LAS unsigned char* lds, int tid, int wave, int lane) {
    p0_ada(a, lds, tid, wave, lane);
    unsigned char* ws = a.ws;
    LAS float* scr = (LAS float*)(lds + wave * 16384);
    const int gw = blockIdx.x * NWAVES + wave, NGW = gridDim.x * NWAVES;
    constexpr int I_SQ = (DM / 64) * (DM / 32);
    constexpr int I_WDQ = (DM / 64) * (512 / 32), I_WDKV = (DM / 64) * (320 / 32), I_WUQ = (512 / 64) * (3072 / 32), I_WUK = (256 / 64) * (DM / 32), I_KV = (DM / 64) * (256 / 32);
    constexpr int I_FG = (DM / 64) * (DFF / 32), I_FD = (DFF / 64) * (DM / 32), I_FL = 2 * I_FG + I_FD;
    constexpr int NITEMS = 4 * I_SQ + 6 * I_SQ + (I_WDQ + I_WDKV + I_WUQ + 2 * I_WUK + I_SQ) + (I_SQ + 2 * I_KV + I_SQ) + 4 * I_FL;
#define TRI(SRC, KD, ND, DST, LDT, ROW0) { constexpr int ni_ = ((KD) / 64) * ((ND) / 32); if (r < ni_) { constexpr int nblk_ = (ND) / 32; const int kb_ = r / nblk_, n0 = 32 * (r % nblk_); \
        transpose_item((SRC), (ND), (bf16*)(DST), (LDT), (ROW0), scr, 64 * kb_, n0, lane); continue; } r -= ni_; }
    for (int it = gw; it < NITEMS; it += NGW) {
        int r = it;
        TRI(a.in[I_AWQ], DM, DM, ws + WS_A_WQKV, DM, n0)
        TRI(a.in[I_AWK], DM, DM, ws + WS_A_WQKV, DM, 2048 + n0)
        TRI(a.in[I_AWV], DM, DM, ws + WS_A_WQKV, DM, 4096 + n0)
        TRI(a.in[I_AWO], DM, DM, ws + WS_A_WO, DM, n0)
        TRI(a.in[I_BWQ], DM, DM, ws + WS_B_WP, DM, n0)
        TRI(a.in[I_BWI], DM, DM, ws + WS_B_WP, DM, 2048 + n0)
        TRI(a.in[I_BWF], DM, DM, ws + WS_B_WP, DM, 4096 + n0)
        TRI(a.in[I_BWF] + (size_t)DM * DM, DM, DM, ws + WS_B_WP, DM, 6144 + n0)
        TRI(a.in[I_BWG], DM, DM, ws + WS_B_WG, DM, n0)
        TRI(a.in[I_BWO], DM, DM, ws + WS_B_WO, DM, n0)
        TRI(a.in[I_CWDQ], DM, 512, ws + WS_C_WD, DM, n0)
        TRI(a.in[I_CWDKV], DM, 320, ws + WS_C_WD, DM, 512 + n0)
        TRI(a.in[I_CWUQ], 512, 3072, ws + WS_C_WUQ, 512, n0)
        TRI(a.in[I_CWUK], 256, DM, ws + WS_C_WUKV, 256, n0)
        TRI(a.in[I_CWUV], 256, DM, ws + WS_C_WUKV, 256, 2048 + n0)
        TRI(a.in[I_CWO], DM, DM, ws + WS_C_WO, DM, n0)
        TRI(a.in[I_DWQ], DM, DM, ws + WS_D_WQKV, DM, n0)
        TRI(a.in[I_DWK], DM, 256, ws + WS_D_WQKV, DM, 2048 + n0)
        TRI(a.in[I_DWV], DM, 256, ws + WS_D_WQKV, DM, 2304 + n0)
        TRI(a.in[I_DWO], DM, DM, ws + WS_D_WO, DM, n0)
        { const int l = r / I_FL; r -= l * I_FL;
          const float* wg = a.in[I_FWG] + (size_t)l * DM * DFF; const float* wu = a.in[I_FWU] + (size_t)l * DM * DFF; const float* wd = a.in[I_FWD] + (size_t)l * DFF * DM;
          unsigned char* gu = ws + WS_F_WGU + (size_t)l * F_WGU_BYTES; unsigned char* dd = ws + WS_F_WD + (size_t)l * F_WD_BYTES;
          TRI(wg, DM, DFF, gu, DM, 256 * (n0 >> 7) + (n0 & 127))
          TRI(wu, DM, DFF, gu, DM, 256 * (n0 >> 7) + 128 + (n0 & 127))
          TRI(wd, DFF, DM, dd, DFF, n0) }
    }
#undef TRI
    const int gtid = blockIdx.x * NTHR + tid, gthreads = gridDim.x * NTHR;
    { v4u* z = (v4u*)(ws + WS_C_WD + (size_t)832 * DM * 2); for (int i = gtid; i < 192 * DM * 2 / 16; i += gthreads) z[i] = (v4u){0u, 0u, 0u, 0u}; }
    cvt_cache(a.in[I_CAK], 2048, (bf16*)(ws + WS_A_KALL), gtid, gthreads);
    cvt_cache(a.in[I_CAV], 2048, (bf16*)(ws + WS_A_VALL), gtid, gthreads);
    cvt_cache(a.in[I_CCKV], 256, (bf16*)(ws + WS_C_CKVALL), gtid, gthreads);
    cvt_cache(a.in[I_CKPE], 64, (bf16*)(ws + WS_C_KPEALL), gtid, gthreads);
    cvt_cache(a.in[I_CDK], 256, (bf16*)(ws + WS_D_KALL), gtid, gthreads);
    cvt_cache(a.in[I_CDV], 256, (bf16*)(ws + WS_D_VALL), gtid, gthreads);
    if (gtid < 1024) { const int pos = gtid >> 4, j = gtid & 15; const float inv = __builtin_amdgcn_exp2f(-(float)j * 0.8304820237218406f);
        const float rev = (float)pos * inv * 0.15915494309189535f; float* R = (float*)(ws + WS_ROPE); R[gtid] = __builtin_amdgcn_cosf(rev); R[1024 + gtid] = __builtin_amdgcn_sinf(rev); }
    if (gtid >= 1024 && gtid < 1024 + 4096) { const int i = gtid - 1024; const float* bl = a.in[I_BLOWER];
        const float v0 = bl[i], v1 = bl[4096 + i], v2 = bl[8192 + i], v3 = bl[12288 + i]; const float mx = fmaxf(fmaxf(v0, v1), fmaxf(v2, v3));
        const float e0 = fast_exp(v0 - mx), e1 = fast_exp(v1 - mx), e2 = fast_exp(v2 - mx), e3 = fast_exp(v3 - mx);
        ((float*)(ws + WS_LBT))[i] = e1 / (e0 + e1 + e2 + e3); }
}

template <bool HAS_Y, bool HAS_NEXT>
__device__ __forceinline__ void nr_phase(const float* xp, const float* xs, float* xout, const float* Y, const float* gate, const float* gpost,
                                         const float* gpre, const float* shift, const float* scale, bf16* XN, int wave, int lane) {
    const int gw = blockIdx.x * NWAVES + wave, NGW = gridDim.x * NWAVES;
    for (int m = gw; m < NTOK; m += NGW) {
        const int cond = m < NCTX ? 0 : 1 + ((m - NCTX) >> 10);
        const float* xr = m < NCTX ? xp + (size_t)m * DM : xs + (size_t)(m - NCTX) * DM;
        f32x4 x[8];
#pragma unroll
        for (int j = 0; j < 8; ++j) x[j] = *(const f32x4*)(xr + 4 * lane + 256 * j);
        if (HAS_Y) {
            f32x4 y[8]; float ss = 0.f;
#pragma unroll
            for (int j = 0; j < 8; ++j) { y[j] = *(const f32x4*)(Y + (size_t)m * DM + 4 * lane + 256 * j); ss += (y[j][0] * y[j][0] + y[j][1] * y[j][1]) + (y[j][2] * y[j][2] + y[j][3] * y[j][3]); }
            const float r = __builtin_amdgcn_rsqf(wave_sum(ss) * (1.0f / DM) + EPS);
#pragma unroll
            for (int j = 0; j < 8; ++j) { const int e = 4 * lane + 256 * j; const f32x4 g = *(const f32x4*)(gate + (size_t)cond * MODW + e), gp = *(const f32x4*)(gpost + e);
                x[j] += g * (y[j] * r * gp); *(f32x4*)(xout + (size_t)m * DM + e) = x[j]; }
        }
        if (HAS_NEXT) {
            float ss = 0.f;
#pragma unroll
            for (int j = 0; j < 8; ++j) ss += (x[j][0] * x[j][0] + x[j][1] * x[j][1]) + (x[j][2] * x[j][2] + x[j][3] * x[j][3]);
            const float r = __builtin_amdgcn_rsqf(wave_sum(ss) * (1.0f / DM) + EPS);
#pragma unroll
            for (int j = 0; j < 8; ++j) { const int e = 4 * lane + 256 * j; const f32x4 gp = *(const f32x4*)(gpre + e), sc = *(const f32x4*)(scale + (size_t)cond * MODW + e), sh = *(const f32x4*)(shift + (size_t)cond * MODW + e);
                const f32x4 h = x[j] * r * gp * (1.0f + sc) + sh; *(v2u*)(XN + (size_t)m * DM + e) = pk4(h); }
        }
    }
}

__device__ __forceinline__ int crow(int r, int h) { return (r & 3) + 8 * (r >> 2) + 4 * h; }
__device__ __forceinline__ s16x4 vtr(LAS const unsigned char* p) { return __builtin_bit_cast(s16x4, __builtin_amdgcn_ds_read_tr16_b64_v4i16((LAS s16x4*)p)); }
#define MFMA32(a, b, c) __builtin_amdgcn_mfma_f32_32x32x16_bf16((a), (b), (c), 0, 0, 0)
constexpr float NEG_BIG = -1e30f;
__device__ __forceinline__ unsigned launder(unsigned x) { asm volatile("" : "+v"(x)); return x; }

template <int DK, int DV, int KPE, int MASK>
struct AttnCfg {
    static constexpr int KSTR = DK * 2 + 16, VSTR = DV * 2 + 64, KBUF = 64 * KSTR, VBUF = 64 * VSTR, BUF = KBUF + VBUF, WSF = 2 * BUF, TOTAL = WSF + 8 * 256;
    static constexpr int DKM = DK - KPE;
    static constexpr int KCH = DKM / 8, NKL = 64 * KCH / NTHR;
    static constexpr int PCH = KPE ? KPE / 8 : 1, NPL = (KPE ? 64 * PCH / NTHR : 0);
    static constexpr int VCH = DV / 8, NVL = 64 * VCH / NTHR;
    static_assert(TOTAL <= RING_BYTES, "attention LDS");
    static_assert(DK != 64 || DV != 128 || TOTAL + 8 * 8192 <= RING_BYTES, "attention A parking");
};

template <int DK, int DV, int KPE, int MASK>
__device__ __forceinline__ void attn_core(LAS unsigned char* lds, const bf16* Qw, int ldq, const bf16* K, int ldk, const bf16* KP, int ldkp, const bf16* V, int ldv,
                                          int ntiles, int jlo, float m_init, float l_init, int qpos0, f32x16 (&o)[DV / 32], float& l_out, int tid, int wave, int lane) {
    typedef AttnCfg<DK, DV, KPE, MASK> C;
    tid = (int)launder((unsigned)threadIdx.x); lane = tid & 63;
    const int r32 = lane & 31, h = lane >> 5;
    LAS float* wsf = (LAS float*)(lds + C::WSF + wave * 256);
    bf16x8 qf[DK / 16];
#pragma unroll
    for (int s = 0; s < DK / 16; ++s) qf[s] = *(const bf16x8*)((const char*)Qw + (unsigned)((r32 * ldq + 16 * s + 8 * h) * 2));
#pragma unroll
    for (int cb = 0; cb < DV / 32; ++cb)
#pragma unroll
        for (int r = 0; r < 16; ++r) o[cb][r] = 0.f;
    float m = m_init, l = (h == 0) ? l_init : 0.f;
    v4u kreg[C::NKL], vreg[C::NVL]; v4u preg[C::NPL > 0 ? C::NPL : 1];
#define ATT_TILE_ROW(ti) ((MASK && (ti) >= 4) ? 256 + 64 * (jlo + (ti) - 4) : 64 * (ti))
#define ATT_ISSUE(ti) do { const int kr_ = ATT_TILE_ROW(ti); \
        _Pragma("unroll") for (int i = 0; i < C::NKL; ++i) { const int idx = tid + NTHR * i, row = idx / C::KCH, ch = idx % C::KCH; kreg[i] = *(const v4u*)((const char*)K + (unsigned)(((kr_ + row) * ldk + 8 * ch) * 2)); } \
        if constexpr (KPE > 0) { _Pragma("unroll") for (int i = 0; i < C::NPL; ++i) { const int idx = tid + NTHR * i, row = idx / C::PCH, ch = idx % C::PCH; preg[i] = *(const v4u*)((const char*)KP + (unsigned)(((kr_ + row) * ldkp + 8 * ch) * 2)); } } \
        _Pragma("unroll") for (int i = 0; i < C::NVL; ++i) { const int idx = tid + NTHR * i, row = idx / C::VCH, ch = idx % C::VCH; vreg[i] = *(const v4u*)((const char*)V + (unsigned)(((kr_ + row) * ldv + 8 * ch) * 2)); } } while (0)
#define ATT_COMMIT(buf_) do { LAS unsigned char* kb_ = lds + (buf_) * C::BUF; LAS unsigned char* vb_ = kb_ + C::KBUF; \
        _Pragma("unroll") for (int i = 0; i < C::NKL; ++i) { const int idx = tid + NTHR * i, row = idx / C::KCH, ch = idx % C::KCH; *(LAS v4u*)(kb_ + row * C::KSTR + 16 * ch) = kreg[i]; } \
        if constexpr (KPE > 0) { _Pragma("unroll") for (int i = 0; i < C::NPL; ++i) { const int idx = tid + NTHR * i, row = idx / C::PCH, ch = idx % C::PCH; *(LAS v4u*)(kb_ + row * C::KSTR + C::DKM * 2 + 16 * ch) = preg[i]; } } \
        _Pragma("unroll") for (int i = 0; i < C::NVL; ++i) { const int idx = tid + NTHR * i, row = idx / C::VCH, ch = idx % C::VCH; *(LAS v4u*)(vb_ + row * C::VSTR + 16 * ch) = vreg[i]; } } while (0)
    ATT_ISSUE(0); ATT_COMMIT(0);
    __syncthreads();
    const int i16 = lane & 15, tq = i16 >> 2, tp = i16 & 3, cbk = (lane >> 4) & 1;
    const int voff = (4 * h + tq) * C::VSTR + (16 * cbk + 4 * tp) * 2;
    const int koff = r32 * C::KSTR + 16 * h;
    for (int ti = 0; ti < ntiles; ++ti) {
        const int buf = ti & 1;
        if (ti + 1 < ntiles) ATT_ISSUE(ti + 1);
        bool need = true, domask = false;
        if (MASK && ti >= 4) { const int k0 = 64 * (jlo + ti - 4); need = (k0 + 63 >= qpos0 - 128) && (k0 <= qpos0 + 31 + 128); domask = !((k0 + 63 - qpos0 <= 128) && (qpos0 + 31 - k0 <= 128)); }
        if (need) {
            LAS const unsigned char* kb = lds + buf * C::BUF; LAS const unsigned char* vb = kb + C::KBUF;
            f32x16 p0, p1;
#pragma unroll
            for (int r = 0; r < 16; ++r) { p0[r] = 0.f; p1[r] = 0.f; }
#pragma unroll
            for (int s = 0; s < DK / 16; ++s) {
                const bf16x8 k0f = *(LAS const bf16x8*)(kb + koff + 32 * s), k1f = *(LAS const bf16x8*)(kb + koff + 32 * C::KSTR + 32 * s);
                p0 = MFMA32(k0f, qf[s], p0); p1 = MFMA32(k1f, qf[s], p1);
            }
            if (MASK) { if (domask) { const int k0 = 64 * (jlo + ti - 4), qp = qpos0 + r32;
#pragma unroll
                for (int r = 0; r < 16; ++r) { const int kp = k0 + crow(r, h); int d0 = qp - kp; d0 = d0 < 0 ? -d0 : d0; int d1 = qp - kp - 32; d1 = d1 < 0 ? -d1 : d1;
                    if (d0 > 128) p0[r] = NEG_BIG; if (d1 > 128) p1[r] = NEG_BIG; } } }
            float mx = fmaxf(p0[0], p1[0]);
#pragma unroll
            for (int r = 1; r < 16; ++r) mx = fmaxf(mx, fmaxf(p0[r], p1[r]));
            mx = fmaxf(mx, __shfl_xor(mx, 32));
            const float mn = fmaxf(m, mx);
            if (__any(mn > m)) {
                const float alpha = __builtin_amdgcn_exp2f(m - mn); l *= alpha; m = mn;
                if (h == 0) wsf[r32] = alpha;
                asm volatile("s_waitcnt lgkmcnt(0)" ::: "memory");
#pragma unroll
                for (int g4 = 0; g4 < 4; ++g4) { const f32x4 f = *(LAS const f32x4*)(wsf + 8 * g4 + 4 * h);
#pragma unroll
                    for (int cb = 0; cb < DV / 32; ++cb) { o[cb][4 * g4] *= f[0]; o[cb][4 * g4 + 1] *= f[1]; o[cb][4 * g4 + 2] *= f[2]; o[cb][4 * g4 + 3] *= f[3]; } }
            }
            float ls = 0.f;
#pragma unroll
            for (int r = 0; r < 16; ++r) { p0[r] = __builtin_amdgcn_exp2f(p0[r] - m); p1[r] = __builtin_amdgcn_exp2f(p1[r] - m); ls += p0[r] + p1[r]; }
            l += ls;
            bf16x8 pa[4];
#pragma unroll
            for (int ks = 0; ks < 4; ++ks) { v4u w;
#pragma unroll
                for (int e = 0; e < 4; ++e) w[e] = (ks < 2) ? cvt_pk_bf16(p0[8 * (ks & 1) + 2 * e], p0[8 * (ks & 1) + 2 * e + 1]) : cvt_pk_bf16(p1[8 * (ks & 1) + 2 * e], p1[8 * (ks & 1) + 2 * e + 1]);
                pa[ks] = __builtin_bit_cast(bf16x8, w); }
#pragma unroll
            for (int cb = 0; cb < DV / 32; ++cb)
#pragma unroll
                for (int ks = 0; ks < 4; ++ks) {
                    const s16x4 lo = vtr(vb + voff + (16 * ks) * C::VSTR + 64 * cb), hi = vtr(vb + voff + (16 * ks + 8) * C::VSTR + 64 * cb);
                    const bf16x8 vf = __builtin_shufflevector(lo, hi, 0, 1, 2, 3, 4, 5, 6, 7);
                    o[cb] = MFMA32(pa[ks], vf, o[cb]);
                }
        }
        if (ti + 1 < ntiles) ATT_COMMIT(buf ^ 1);
        __syncthreads();
    }
    l_out = l + __shfl_xor(l, 32);
}

__device__ __forceinline__ void row_recip(LAS float* wsf, float l, int r32, int h, float (&rl)[16]) {
    if (h == 0) wsf[32 + r32] = __builtin_amdgcn_rcpf(l);
    asm volatile("s_waitcnt lgkmcnt(0)" ::: "memory");
#pragma unroll
    for (int g4 = 0; g4 < 4; ++g4) { const f32x4 f = *(LAS const f32x4*)(wsf + 32 + 8 * g4 + 4 * h); rl[4 * g4] = f[0]; rl[4 * g4 + 1] = f[1]; rl[4 * g4 + 2] = f[2]; rl[4 * g4 + 3] = f[3]; }
}

__device__ __forceinline__ void attn_phase_A(const Args& a, LAS unsigned char* lds, int tid, int wave, int lane) {
    typedef AttnCfg<64, 128, 0, 0> C;
    unsigned char* ws = a.ws;
    const bf16* Q = (const bf16*)(ws + WS_A_Q); const bf16* KA = (const bf16*)(ws + WS_A_KALL); const bf16* VA = (const bf16*)(ws + WS_A_VALL); bf16* O = (bf16*)(ws + WS_A_O);
    const int r32 = lane & 31, h = lane >> 5;
    LAS float* wsf = (LAS float*)(lds + C::WSF + wave * 256);
    const float* lp = a.in[I_ALAM];
    const float s1 = wave_sum(lp[lane] * lp[64 + lane]), s2 = wave_sum(lp[128 + lane] * lp[192 + lane]);
    const float lam_init = 0.2f, lam = fast_exp(s1) - fast_exp(s2) + lam_init;
    const float* subln = a.in[I_ASUBLN];
    const int G = gridDim.x, vcu = (G % 8 == 0) ? (blockIdx.x % 8) * (G / 8) + blockIdx.x / 8 : blockIdx.x;
    for (int u = vcu; u < 512; u += G) {
        int qrow0, krow0, ntiles, head;
        if (u < 256) { const int b = u >> 6; head = (u >> 2) & 15; const int qb = u & 3; qrow0 = NCTX + 1024 * b + 256 * qb; krow0 = NCTX + 1280 * b; ntiles = 20; }
        else { const int v = u - 256, b = v >> 4; head = v & 15; qrow0 = 256 * b; krow0 = 256 * b; ntiles = 4; }
        const int qw = qrow0 + 32 * wave;
        LAS v4u* park = (LAS v4u*)(lds + C::TOTAL + wave * 8192) + lane;
        { f32x16 ob[4]; float lb_;
          attn_core<64, 128, 0, 0>(lds, Q + (size_t)qw * DM + 128 * head + 64, DM, KA + (size_t)krow0 * DM + 128 * head + 64, DM, nullptr, 0, VA + (size_t)krow0 * DM + 128 * head, DM, ntiles, 0, NEG_BIG, 0.f, 0, ob, lb_, tid, wave, lane);
          float rl[16]; row_recip(wsf, lb_, r32, h, rl);
#pragma unroll
          for (int cb = 0; cb < 4; ++cb)
#pragma unroll
              for (int e4 = 0; e4 < 2; ++e4) { v4u w;
#pragma unroll
                  for (int e = 0; e < 4; ++e) { const int r = 8 * e4 + 2 * e; w[e] = cvt_pk_bf16(ob[cb][r] * (lam * rl[r]), ob[cb][r + 1] * (lam * rl[r + 1])); }
                  park[(cb * 2 + e4) * 64] = w; } }
        f32x16 oa[4]; float la;
        attn_core<64, 128, 0, 0>(lds, Q + (size_t)qw * DM + 128 * head, DM, KA + (size_t)krow0 * DM + 128 * head, DM, nullptr, 0, VA + (size_t)krow0 * DM + 128 * head, DM, ntiles, 0, NEG_BIG, 0.f, 0, oa, la, tid, wave, lane);
        float rl[16]; row_recip(wsf, la, r32, h, rl);
        float ss[16];
#pragma unroll
        for (int r = 0; r < 16; ++r) ss[r] = 0.f;
#pragma unroll
        for (int cb = 0; cb < 4; ++cb)
#pragma unroll
            for (int e4 = 0; e4 < 2; ++e4) { const v4u w = park[(cb * 2 + e4) * 64];
#pragma unroll
                for (int e = 0; e < 4; ++e) { const int r = 8 * e4 + 2 * e;
                    const float v0 = oa[cb][r] * rl[r] - bflo(w[e]), v1 = oa[cb][r + 1] * rl[r + 1] - bfhi(w[e]);
                    oa[cb][r] = v0; oa[cb][r + 1] = v1; ss[r] += v0 * v0; ss[r + 1] += v1 * v1; } }
#pragma unroll
        for (int r = 0; r < 16; ++r) { float s = ss[r]; s += __shfl_xor(s, 1); s += __shfl_xor(s, 2); s += __shfl_xor(s, 4); s += __shfl_xor(s, 8); s += __shfl_xor(s, 16);
            ss[r] = __builtin_amdgcn_rsqf(s * (1.0f / 128.0f) + EPS) * (1.0f - lam_init); }
        const unsigned lbase_ = launder((unsigned)((4 * h * DM + r32) * 2));
#pragma unroll
        for (int cb = 0; cb < 4; ++cb) { const float g = subln[32 * cb + r32];
#pragma unroll
            for (int r = 0; r < 16; ++r) { const float v = oa[cb][r] * ss[r] * g; *(bf16*)((char*)O + (lbase_ + (unsigned)(((qw + (r & 3) + 8 * (r >> 2)) * DM + 128 * head + 32 * cb) * 2))) = (bf16)(cvt_pk_bf16(v, 0.f) & 0xffffu); } }
    }
}

template <int NCB>
__device__ __forceinline__ void attn_store(bf16* O, int qw, int colbase, f32x16 (&o)[NCB], float l, LAS float* wsf, int r32, int h) {
    float rl[16]; row_recip(wsf, l, r32, h, rl);
    const unsigned lbase_ = launder((unsigned)((4 * h * DM + r32) * 2));
#pragma unroll
    for (int cb = 0; cb < NCB; ++cb)
#pragma unroll
        for (int r = 0; r < 16; ++r) { const float v = o[cb][r] * rl[r]; *(bf16*)((char*)O + (lbase_ + (unsigned)(((qw + (r & 3) + 8 * (r >> 2)) * DM + colbase + 32 * cb) * 2))) = (bf16)(cvt_pk_bf16(v, 0.f) & 0xffffu); }
}
__device__ __forceinline__ void attn_phase_C(const Args& a, LAS unsigned char* lds, int tid, int wave, int lane) {
    typedef AttnCfg<192, 128, 64, 0> C;
    unsigned char* ws = a.ws;
    const bf16* Q = (const bf16*)(ws + WS_C_Q); const bf16* KN = (const bf16*)(ws + WS_C_KN); const bf16* KP = (const bf16*)(ws + WS_C_KPEALL); const bf16* VV = (const bf16*)(ws + WS_C_VV); bf16* O = (bf16*)(ws + WS_C_O);
    const int r32 = lane & 31, h = lane >> 5;
    LAS float* wsf = (LAS float*)(lds + C::WSF + wave * 256);
    const int G = gridDim.x, vcu = (G % 8 == 0) ? (blockIdx.x % 8) * (G / 8) + blockIdx.x / 8 : blockIdx.x;
    for (int u = vcu; u < 512; u += G) {
        int qrow0, krow0, ntiles, head;
        if (u < 256) { const int b = u >> 6; head = (u >> 2) & 15; const int qb = u & 3; qrow0 = NCTX + 1024 * b + 256 * qb; krow0 = NCTX + 1280 * b; ntiles = 20; }
        else { const int v = u - 256, b = v >> 4; head = v & 15; qrow0 = 256 * b; krow0 = 256 * b; ntiles = 4; }
        const int qw = qrow0 + 32 * wave;
        f32x16 o[4]; float l;
        attn_core<192, 128, 64, 0>(lds, Q + (size_t)qw * 3072 + 192 * head, 3072, KN + (size_t)krow0 * DM + 128 * head, DM, KP + (size_t)krow0 * 64, 64, VV + (size_t)krow0 * DM + 128 * head, DM,
                                   ntiles, 0, NEG_BIG, 0.f, 0, o, l, tid, wave, lane);
        attn_store<4>(O, qw, 128 * head, o, l, wsf, r32, h);
    }
}
__device__ __forceinline__ void attn_phase_D(const Args& a, LAS unsigned char* lds, int tid, int wave, int lane) {
    typedef AttnCfg<64, 64, 0, 1> C;
    unsigned char* ws = a.ws;
    const bf16* Q = (const bf16*)(ws + WS_D_Q); const bf16* KA = (const bf16*)(ws + WS_D_KALL); const bf16* VA = (const bf16*)(ws + WS_D_VALL); bf16* O = (bf16*)(ws + WS_D_O);
    const int r32 = lane & 31, h = lane >> 5;
    LAS float* wsf = (LAS float*)(lds + C::WSF + wave * 256);
    const float* sink = a.in[I_DSINK];
    const int G = gridDim.x, vcu = (G % 8 == 0) ? (blockIdx.x % 8) * (G / 8) + blockIdx.x / 8 : blockIdx.x;
    for (int u = vcu; u < 1024; u += G) {
        int qrow0, krow0, ntiles, hq, jlo = 0, qpos0 = 0;
        if (u < 512) { const int b = u >> 7; hq = (u >> 2) & 31; const int qb = u & 3; qrow0 = NCTX + 1024 * b + 256 * qb; krow0 = NCTX + 1280 * b;
            jlo = qb == 0 ? 0 : 4 * qb - 2; const int jhi = (4 * qb + 5) < 15 ? (4 * qb + 5) : 15; ntiles = 4 + jhi - jlo + 1; qpos0 = 256 * qb + 32 * wave; }
        else { const int v = u - 512, b = v >> 5; hq = v & 31; qrow0 = 256 * b; krow0 = 256 * b; ntiles = 4; }
        const int qw = qrow0 + 32 * wave, kvh = hq >> 3;
        f32x16 o[2]; float l;
        attn_core<64, 64, 0, 1>(lds, Q + (size_t)qw * DM + 64 * hq, DM, KA + (size_t)krow0 * 256 + 64 * kvh, 256, nullptr, 0, VA + (size_t)krow0 * 256 + 64 * kvh, 256,
                                ntiles, jlo, sink[hq] * LOG2E, 1.0f, qpos0, o, l, tid, wave, lane);
        attn_store<2>(O, qw, 64 * hq, o, l, wsf, r32, h);
    }
}

constexpr int SC_IMG = 8192, SC_QD = 0, SC_KI = SC_IMG, SC_KE = 2 * SC_IMG, SC_VT = 3 * SC_IMG, SC_BUF = 4 * SC_IMG;
constexpr int SC_EL_OFF = LDSCTL_OFF + 1024;
static_assert(4 * SC_BUF <= RING_BYTES && SC_EL_OFF + 4 * 512 <= LDS_BYTES, "scan LDS");
constexpr size_t SC_SEC = (size_t)2048 * 8192;

__device__ __forceinline__ void scan_unit(const Args& a, LAS unsigned char* lds, int tok0, int T, int head, const float* st_f, const float* st_b, float* out_f, float* out_b) {
    unsigned char* ws = a.ws;
    const int tid = (int)launder((unsigned)threadIdx.x), lane = tid & 63, wave = __builtin_amdgcn_readfirstlane(tid >> 6);
    const int dir = wave >> 2, wv = wave & 3, r32 = lane & 31, h = lane >> 5;
    const int td = tid & 255, dch = td >> 1, g = td & 1;
    const size_t hb = (size_t)head * 256 * 4096;
    const bf16* QTg = (const bf16*)(ws + WS_B_QT) + hb;
    const bf16* VTg = (const bf16*)(ws + WS_B_VT) + hb;
    const bf16* LFg = (const bf16*)(ws + WS_B_LF) + (size_t)dir * SC_SEC + hb;
    const bf16* KKg = (const bf16*)(ws + WS_B_KK) + (size_t)dir * SC_SEC + hb;
    bf16* OTg = (bf16*)(ws + WS_B_OT) + (size_t)dir * SC_SEC + hb;
    const int nch = T / 32, chunk0 = tok0 >> 5;
    f32x16 S[4];
    { const float* st = dir ? st_b : st_f; const unsigned lb_ = launder((unsigned)((4 * h * 128 + 32 * wv + r32) * 4));
#pragma unroll
      for (int dt = 0; dt < 4; ++dt)
#pragma unroll
          for (int r = 0; r < 16; ++r) S[dt][r] = st ? *(const float*)((const char*)st + (lb_ + (unsigned)((32 * dt + (r & 3) + 8 * (r >> 2)) * 512))) : 0.f; }
    const int i16 = lane & 15, tq = i16 >> 2, tp = i16 & 3, cbk = (lane >> 4) & 1, cch = 2 * cbk + (tp >> 1), b8 = 8 * (tp & 1);
    const int o1a = (8 * h + tq) * 64 + 16 * (cch ^ (2 * h)) + b8, o1b = (8 * h + tq + 4) * 64 + 16 * (cch ^ (2 * h + 1)) + b8;
    const int o2a = (4 * h + tq) * 64 + 16 * (cch ^ h) + b8, o2b = (4 * h + tq + 8) * 64 + 16 * (cch ^ (h ^ 2)) + b8;
    const int key = (r32 >> 2) & 3, key16 = 16 * key, kb0 = r32 * 64 + 16 * (h ^ key), kb1 = r32 * 64 + 16 * ((h ^ 2) ^ key);
    const int vrow = (32 * wv + r32) * 64 + 8 * h;
    const int wkey = (dch >> 2) & 3, w0 = dch * 64 + 16 * ((2 * g) ^ wkey), w1 = dch * 64 + 16 * ((2 * g + 1) ^ wkey);
    const unsigned toff = (unsigned)(dch * 32 + 16 * g);
    v4u lfr[2], kkr[2], qr[2], vr[2];
#define SC_LOAD(c_) do { const int cc_ = (c_) < nch ? (c_) : nch - 1; const int ci_ = dir ? nch - 1 - cc_ : cc_; const size_t eo_ = (size_t)(chunk0 + ci_) * 4096 + toff; \
        const v4u* p_ = (const v4u*)(LFg + eo_); lfr[0] = p_[0]; lfr[1] = p_[1]; p_ = (const v4u*)(KKg + eo_); kkr[0] = p_[0]; kkr[1] = p_[1]; \
        p_ = (const v4u*)(QTg + eo_); qr[0] = p_[0]; qr[1] = p_[1]; p_ = (const v4u*)(VTg + eo_); vr[0] = p_[0]; vr[1] = p_[1]; } while (0)
    float bc[16], eL; v4u wq[2], wi[2], we[2];
#define SC_PREP_BEGIN() do { float own_[16]; \
        _Pragma("unroll") for (int i = 0; i < 2; ++i) _Pragma("unroll") for (int e = 0; e < 4; ++e) { own_[8 * i + 2 * e] = bflo(lfr[i][e]); own_[8 * i + 2 * e + 1] = bfhi(lfr[i][e]); } \
        float tot_ = 0.f; _Pragma("unroll") for (int s = 0; s < 16; ++s) tot_ += own_[s]; \
        const float oth_ = __shfl_xor(tot_, 1); \
        if (dir == 0) { float acc_ = g ? oth_ : 0.f; _Pragma("unroll") for (int s = 0; s < 16; ++s) { acc_ += own_[s]; bc[s] = acc_; } } \
        else { float acc_ = g ? 0.f : oth_; _Pragma("unroll") for (int s = 15; s >= 0; --s) { acc_ += own_[s]; bc[s] = acc_; } } \
        eL = fast_exp(tot_ + oth_); } while (0)
#define SC_PREP_PAIR(i_, e_) do { const float b0_ = bc[8 * (i_) + 2 * (e_)], b1_ = bc[8 * (i_) + 2 * (e_) + 1]; \
        const float e0_ = fast_exp(b0_), e1_ = fast_exp(b1_), i0_ = fast_exp(-b0_), i1_ = fast_exp(-b1_); \
        const float q0_ = bflo(qr[i_][e_]), q1_ = bfhi(qr[i_][e_]), k0_ = bflo(kkr[i_][e_]) * i0_, k1_ = bfhi(kkr[i_][e_]) * i1_; \
        wq[i_][e_] = cvt_pk_bf16(q0_ * e0_, q1_ * e1_); wi[i_][e_] = cvt_pk_bf16(k0_, k1_); we[i_][e_] = cvt_pk_bf16(k0_ * eL, k1_ * eL); } while (0)
#define SC_PREP_WRITE(Lp_, ELp_) do { \
        *(LAS v4u*)((Lp_) + SC_QD + w0) = wq[0]; *(LAS v4u*)((Lp_) + SC_QD + w1) = wq[1]; *(LAS v4u*)((Lp_) + SC_KI + w0) = wi[0]; *(LAS v4u*)((Lp_) + SC_KI + w1) = wi[1]; \
        *(LAS v4u*)((Lp_) + SC_KE + w0) = we[0]; *(LAS v4u*)((Lp_) + SC_KE + w1) = we[1]; *(LAS v4u*)((Lp_) + SC_VT + w0) = vr[0]; *(LAS v4u*)((Lp_) + SC_VT + w1) = vr[1]; \
        if (g == 0) *(LAS float*)((ELp_) + 4 * dch) = eL; } while (0)
#define SC_CAT(x, y) __builtin_shufflevector(x, y, 0, 1, 2, 3, 4, 5, 6, 7)
    SC_LOAD(0);
    { LAS unsigned char* Lp = lds + dir * SC_BUF; LAS unsigned char* ELp = lds + SC_EL_OFF + dir * 512;
      SC_PREP_BEGIN();
      SC_PREP_PAIR(0, 0); SC_PREP_PAIR(0, 1); SC_PREP_PAIR(0, 2); SC_PREP_PAIR(0, 3); SC_PREP_PAIR(1, 0); SC_PREP_PAIR(1, 1); SC_PREP_PAIR(1, 2); SC_PREP_PAIR(1, 3);
      SC_PREP_WRITE(Lp, ELp); }
    SC_LOAD(1);
    __syncthreads();
    for (int c = 0; c < nch; ++c) {
        LAS const unsigned char* L = lds + ((c & 1) * 2 + dir) * SC_BUF; LAS const unsigned char* EL = lds + SC_EL_OFF + ((c & 1) * 2 + dir) * 512;
        LAS unsigned char* Lp = lds + (((c + 1) & 1) * 2 + dir) * SC_BUF; LAS unsigned char* ELp = lds + SC_EL_OFF + (((c + 1) & 1) * 2 + dir) * 512;
        SC_PREP_BEGIN();
        f32x16 pt;
#pragma unroll
        for (int r = 0; r < 16; ++r) pt[r] = 0.f;
#define SC_QK(ks) do { const s16x4 a0 = vtr(L + SC_KI + 1024 * (ks) + o1a), a1 = vtr(L + SC_KI + 1024 * (ks) + o1b), b0 = vtr(L + SC_QD + 1024 * (ks) + o1a), b1 = vtr(L + SC_QD + 1024 * (ks) + o1b); \
            pt = MFMA32(SC_CAT(a0, a1), SC_CAT(b0, b1), pt); } while (0)
        SC_QK(0); SC_QK(1); SC_PREP_PAIR(0, 0); SC_QK(2); SC_QK(3); SC_PREP_PAIR(0, 1); SC_QK(4); SC_QK(5); SC_PREP_PAIR(0, 2); SC_QK(6); SC_QK(7); SC_PREP_PAIR(0, 3);
#undef SC_QK
#pragma unroll
        for (int r = 0; r < 16; ++r) { const int s = crow(r, h); const bool keep = dir ? (s >= r32) : (s <= r32); pt[r] = keep ? pt[r] : 0.f; }
        f32x16 o;
#pragma unroll
        for (int r = 0; r < 16; ++r) o[r] = 0.f;
#pragma unroll
        for (int ks = 0; ks < 2; ++ks) { v4u w;
#pragma unroll
            for (int e = 0; e < 4; ++e) w[e] = cvt_pk_bf16(pt[8 * ks + 2 * e], pt[8 * ks + 2 * e + 1]);
            const v2u v0 = *(LAS const v2u*)(L + SC_VT + vrow + ((32 * ks) ^ key16)), v1 = *(LAS const v2u*)(L + SC_VT + vrow + ((32 * ks + 16) ^ key16));
            const v4u vv = (v4u){v0.x, v0.y, v1.x, v1.y};
            o = MFMA32(__builtin_bit_cast(bf16x8, w), __builtin_bit_cast(bf16x8, vv), o); }
#define SC_QS(dt, ks) do { v4u w_; _Pragma("unroll") for (int e = 0; e < 4; ++e) w_[e] = cvt_pk_bf16(S[dt][8 * (ks) + 2 * e], S[dt][8 * (ks) + 2 * e + 1]); \
            const s16x4 a0 = vtr(L + SC_QD + (32 * (dt) + 16 * (ks)) * 64 + o2a), a1 = vtr(L + SC_QD + (32 * (dt) + 16 * (ks)) * 64 + o2b); \
            o = MFMA32(SC_CAT(a0, a1), __builtin_bit_cast(bf16x8, w_), o); } while (0)
        SC_QS(0, 0); SC_QS(0, 1); SC_PREP_PAIR(1, 0); SC_QS(1, 0); SC_QS(1, 1); SC_PREP_PAIR(1, 1); SC_QS(2, 0); SC_QS(2, 1); SC_PREP_PAIR(1, 2); SC_QS(3, 0); SC_QS(3, 1); SC_PREP_PAIR(1, 3);
#undef SC_QS
        SC_PREP_WRITE(Lp, ELp);
        SC_LOAD(c + 2);
#pragma unroll
        for (int dt = 0; dt < 4; ++dt) {
#pragma unroll
            for (int g4 = 0; g4 < 4; ++g4) { const f32x4 f = *(LAS const f32x4*)(EL + 4 * (32 * dt + 8 * g4 + 4 * h));
                S[dt][4 * g4] *= f[0]; S[dt][4 * g4 + 1] *= f[1]; S[dt][4 * g4 + 2] *= f[2]; S[dt][4 * g4 + 3] *= f[3]; }
#pragma unroll
            for (int ks = 0; ks < 2; ++ks) {
                const bf16x8 ak = *(LAS const bf16x8*)(L + SC_KE + 32 * dt * 64 + (ks ? kb1 : kb0)), bv = *(LAS const bf16x8*)(L + SC_VT + 32 * wv * 64 + (ks ? kb1 : kb0));
                S[dt] = MFMA32(ak, bv, S[dt]); }
        }
        { const int ci = dir ? nch - 1 - c : c; bf16* op = OTg + (size_t)(chunk0 + ci) * 4096 + (32 * wv + r32) * 32 + 4 * h;
#pragma unroll
          for (int g4 = 0; g4 < 4; ++g4) { v2u w; w.x = cvt_pk_bf16(o[4 * g4], o[4 * g4 + 1]); w.y = cvt_pk_bf16(o[4 * g4 + 2], o[4 * g4 + 3]); *(v2u*)(op + 8 * g4) = w; } }
        __syncthreads();
    }
#undef SC_LOAD
#undef SC_PREP_BEGIN
#undef SC_PREP_PAIR
#undef SC_PREP_WRITE
    { float* so = dir ? out_b : out_f; const unsigned lb_ = launder((unsigned)((4 * h * 128 + 32 * wv + r32) * 4));
      if (so) {
#pragma unroll
          for (int dt = 0; dt < 4; ++dt)
#pragma unroll
              for (int r = 0; r < 16; ++r) *(float*)((char*)so + (lb_ + (unsigned)((32 * dt + (r & 3) + 8 * (r >> 2)) * 512))) = S[dt][r]; } }
    asm volatile("s_waitcnt vmcnt(0)" ::: "memory");
    __syncthreads();
    { const bf16* OF = (const bf16*)(ws + WS_B_OT) + hb; const bf16* OB = OF + SC_SEC;
      const bf16* Gg = (const bf16*)(ws + WS_B_G); bf16* O = (bf16*)(ws + WS_B_O); const float* gn = a.in[I_BGNORM];
      const int tg = lane & 3, cgp = lane >> 2;
      float gnv[8];
#pragma unroll
      for (int j = 0; j < 8; ++j) gnv[j] = gn[8 * cgp + j];
      for (int ci = wave; ci < nch; ci += NWAVES) {
          const size_t cb = (size_t)(chunk0 + ci) * 4096 + 8 * tg;
          float ov[8][8]; float ss[8];
#pragma unroll
          for (int e = 0; e < 8; ++e) ss[e] = 0.f;
#pragma unroll
          for (int j = 0; j < 8; ++j) { const v4u pf = *(const v4u*)(OF + cb + (8 * cgp + j) * 32), pb = *(const v4u*)(OB + cb + (8 * cgp + j) * 32);
#pragma unroll
              for (int e = 0; e < 4; ++e) { const float x0 = bflo(pf[e]) + bflo(pb[e]), x1 = bfhi(pf[e]) + bfhi(pb[e]); ov[j][2 * e] = x0; ov[j][2 * e + 1] = x1; ss[2 * e] += x0 * x0; ss[2 * e + 1] += x1 * x1; } }
#pragma unroll
          for (int e = 0; e < 8; ++e) { float s = ss[e]; s += __shfl_xor(s, 4); s += __shfl_xor(s, 8); s += __shfl_xor(s, 16); s += __shfl_xor(s, 32); ss[e] = __builtin_amdgcn_rsqf(s * (1.0f / 128.0f) + EPS); }
#pragma unroll
          for (int e = 0; e < 8; ++e) { const size_t tk = (size_t)tok0 + 32 * ci + 8 * tg + e; const v4u gv = *(const v4u*)(Gg + tk * DM + 128 * head + 8 * cgp);
              v4u w;
#pragma unroll
              for (int q = 0; q < 4; ++q) w[q] = cvt_pk_bf16(ov[2 * q][e] * ss[e] * gnv[2 * q] * bflo(gv[q]), ov[2 * q + 1][e] * ss[e] * gnv[2 * q + 1] * bfhi(gv[q]));
              *(v4u*)(O + tk * DM + 128 * head + 8 * cgp) = w; }
      } }
    __syncthreads();
}

__device__ __forceinline__ void scan_phase(const Args& a, LAS unsigned char* lds) {
    const int G = gridDim.x, vcu = (G % 8 == 0) ? (blockIdx.x % 8) * (G / 8) + blockIdx.x / 8 : blockIdx.x;
    int u0 = vcu, ustep = G, uend = 320;
    if (G == 256 && vcu >= 64) { ustep = 192; }
    if (G == 256 && vcu < 64) { uend = 64; }
    for (int u = u0; u < uend; u += ustep) {
        if (u < 64) { const int b = u >> 4, head = u & 15;
            scan_unit(a, lds, NCTX + 1024 * b, 1024, head, a.in[I_SBF] + (size_t)(b * 16 + head) * 16384, a.in[I_SBB] + (size_t)(b * 16 + head) * 16384, nullptr, nullptr); }
        else { const int v = u - 64, b = v >> 4, head = v & 15;
            scan_unit(a, lds, 256 * b, 256, head, nullptr, nullptr, a.out + OUT_BF + (size_t)(b * 16 + head) * 16384, a.out + OUT_BB + (size_t)(b * 16 + head) * 16384); }
    }
}

__device__ __forceinline__ void mla_thin_phase(const Args& a, int wave, int lane) {
    unsigned char* ws = a.ws;
    const float* QD = (const float*)(ws + WS_C_QD); bf16* QDN = (bf16*)(ws + WS_C_QDN); bf16* CKV = (bf16*)(ws + WS_C_CKVALL); bf16* KPE = (bf16*)(ws + WS_C_KPEALL);
    const float* ROPE = (const float*)(ws + WS_ROPE); const float* qn = a.in[I_CQNORM]; const float* kvn = a.in[I_CKVNORM];
    const int gw = blockIdx.x * NWAVES + wave, NGW = gridDim.x * NWAVES;
    for (int m = gw; m < NTOK; m += NGW) {
        const bool lat = m >= NCTX; const int t = (m - NCTX) & 1023;
        const int kr = lat ? NCTX + 1280 * ((m - NCTX) >> 10) + 256 + t : m;
        const float* row = QD + (size_t)m * 1024;
        f32x4 v[4];
#pragma unroll
        for (int j = 0; j < 4; ++j) v[j] = *(const f32x4*)(row + 4 * lane + 256 * j);
        { float ss = 0.f;
#pragma unroll
          for (int j = 0; j < 2; ++j) ss += (v[j][0] * v[j][0] + v[j][1] * v[j][1]) + (v[j][2] * v[j][2] + v[j][3] * v[j][3]);
          const float rs = __builtin_amdgcn_rsqf(wave_sum(ss) * (1.0f / 512.0f) + EPS);
#pragma unroll
          for (int j = 0; j < 2; ++j) { const f32x4 g = *(const f32x4*)(qn + 4 * lane + 256 * j); *(v2u*)(QDN + (size_t)m * 512 + 4 * lane + 256 * j) = pk4(v[j] * rs * g); } }
        { const float ss = (v[2][0] * v[2][0] + v[2][1] * v[2][1]) + (v[2][2] * v[2][2] + v[2][3] * v[2][3]);
          const float rs = __builtin_amdgcn_rsqf(wave_sum(ss) * (1.0f / 256.0f) + EPS);
          const f32x4 g = *(const f32x4*)(kvn + 4 * lane); const f32x4 o = v[2] * rs * g;
          *(v2u*)(CKV + (size_t)kr * 256 + 4 * lane) = pk4(o);
          if (!lat) *(f32x4*)(a.out + OUT_CKV + (size_t)m * 256 + 4 * lane) = o; }
        { const f32x4 x = v[3]; f32x4 xp;
#pragma unroll
          for (int i = 0; i < 4; ++i) xp[i] = __shfl_xor(x[i], 4);
          f32x4 o = x;
          if (lat) { const int l16 = lane & 15, half = l16 >> 3, part = (l16 & 7) >> 2, pos = half ? (t & 63) : (t >> 6);
              const f32x4 cs = *(const f32x4*)(ROPE + pos * 16 + 4 * (l16 & 3)), sn = *(const f32x4*)(ROPE + 1024 + pos * 16 + 4 * (l16 & 3));
              o = part == 0 ? x * cs - xp * sn : x * cs + xp * sn; }
          if (lane < 16) { *(v2u*)(KPE + (size_t)kr * 64 + 4 * lane) = pk4(o); if (!lat) *(f32x4*)(a.out + OUT_KPE + (size_t)m * 64 + 4 * lane) = o; } }
    }
}

#ifndef MK_ONE_LAUNCH
#define MK_ONE_LAUNCH 1
#endif
constexpr int N_PHASES = 2 + 9 * 4;
__host__ __device__ constexpr bool phase_used(int p) { if (p < 2) return true; const int l = (p - 2) / 9, s = (p - 2) % 9; if (s >= 4) return true; return (l == 2) ? true : (s < 2); }
#ifndef PROBE_G
#define PROBE_G 1
#endif
#ifndef PROBE_M
#define PROBE_M 1
#endif
#ifndef PROBE_MA
#define PROBE_MA PROBE_M
#endif
#ifndef PROBE_MB
#define PROBE_MB PROBE_M
#endif
#ifndef PROBE_MC
#define PROBE_MC PROBE_M
#endif
#ifndef PROBE_MD
#define PROBE_MD PROBE_M
#endif
#ifndef PROBE_P
#define PROBE_P 1
#endif
#ifndef PROBE_FU
#define PROBE_FU 1
#endif
#define PG8_ALIGN true
#define PG8_SP2 true


struct Ctx { LAS unsigned char* lds; unsigned char* ws; const float* MOD; const float* ROPE; float* xout; bf16* XN; float* Y; bf16* Hb; int G, bid, lo, hi; };
#define IN(k) (lo <= (k) && (k) < hi)
#if MK_ONE_LAUNCH
#define GRID_BAR() xcd_barrier(bar)
#else
#define GRID_BAR() do {} while (0)
#endif
#define SEAM(k) do { if (IN(k) && (k) + 1 < hi) GRID_BAR(); } while (0)
template <int L>
__device__ __forceinline__ void layer_body(const Args& args, const Ctx& cx, const XcdBarrier& bar) {
    LAS unsigned char* lds = cx.lds; unsigned char* ws = cx.ws; const float* MOD = cx.MOD; const float* ROPE = cx.ROPE; float* xout = cx.xout; bf16* XN = cx.XN; float* Y = cx.Y; bf16* Hb = cx.Hb;
    const int G = cx.G, bid = cx.bid, lo = cx.lo, hi = cx.hi;
    const int tid = (int)launder((unsigned)threadIdx.x), lane = tid & 63, wave = __builtin_amdgcn_readfirstlane(tid >> 6);
    {
        constexpr int l = L; constexpr int pb = 2 + 9 * l;
        const float* MODl = MOD + (size_t)l * 5 * MODW;
        const bf16* Omix = nullptr; const bf16* Wo = nullptr;
        if constexpr (l == 0) {
            Omix = (const bf16*)(ws + WS_A_O); Wo = (const bf16*)(ws + WS_A_WO);
            if (IN(pb + 0)) {
                pg8::Gemm g{XN, (const bf16*)(ws + WS_A_WQKV), NTOK, 6144, DM}; pg8::StaticOrder S; S.init(NTOK, 6144, G, bid);
                pg8::EpiQKV E{(bf16*)(ws + WS_A_Q), (bf16*)(ws + WS_A_KALL), (bf16*)(ws + WS_A_VALL), args.out + OUT_AK, args.out + OUT_AV, ROPE, 8, 8, DM, DM, 0.125f * LOG2E};
                pg8::gemm_phase<pg8::EpiQKV, pg8::StaticOrder, PG8_ALIGN, PG8_SP2>(lds + RING_OFF, g, S, E); if constexpr (PROBE_G == 2) { asm volatile("" ::: "memory"); pg8::gemm_phase<pg8::EpiQKV, pg8::StaticOrder, PG8_ALIGN, PG8_SP2>(lds + RING_OFF, g, S, E); }
            } SEAM(pb + 0);
            if (IN(pb + 1)) {
#ifndef NO_ATTN_A
 attn_phase_A(args, lds, tid, wave, lane); if constexpr (PROBE_MA == 2) { asm volatile("" ::: "memory"); attn_phase_A(args, lds, tid, wave, lane); }
#endif
 } SEAM(pb + 1);
        } else if constexpr (l == 1) {
            Omix = (const bf16*)(ws + WS_B_O); Wo = (const bf16*)(ws + WS_B_WO);
            if (IN(pb + 0)) {
                { pg8::Gemm g{(const bf16*)(ws + WS_B_WP), XN, 8192, NTOK, DM}; pg8::StaticOrder S; S.init(8192, NTOK, G, bid);
                  pg8::EpiHgrnT E{(bf16*)(ws + WS_B_QT), (bf16*)(ws + WS_B_VT), (bf16*)(ws + WS_B_LF), (bf16*)(ws + WS_B_KK), (const float*)(ws + WS_LBT)};
                  pg8::gemm_phase<pg8::EpiHgrnT, pg8::StaticOrder, PG8_ALIGN, PG8_SP2>(lds + RING_OFF, g, S, E); if constexpr (PROBE_G == 2) { asm volatile("" ::: "memory"); pg8::gemm_phase<pg8::EpiHgrnT, pg8::StaticOrder, PG8_ALIGN, PG8_SP2>(lds + RING_OFF, g, S, E); } }
                { pg8::Gemm g{XN, (const bf16*)(ws + WS_B_WG), NTOK, DM, DM}; pg8::StaticOrder S; S.init(NTOK, DM, G, bid);
                  pg8::EpiBf16<1> E{(bf16*)(ws + WS_B_G), DM, 0, 0};
                  pg8::gemm_phase<pg8::EpiBf16<1>, pg8::StaticOrder, PG8_ALIGN, PG8_SP2>(lds + RING_OFF, g, S, E); if constexpr (PROBE_G == 2) { asm volatile("" ::: "memory"); pg8::gemm_phase<pg8::EpiBf16<1>, pg8::StaticOrder, PG8_ALIGN, PG8_SP2>(lds + RING_OFF, g, S, E); } }
            } SEAM(pb + 0);
            if (IN(pb + 1)) {
#ifndef NO_SCAN
 scan_phase(args, lds); if constexpr (PROBE_MB == 2) { asm volatile("" ::: "memory"); scan_phase(args, lds); }
#endif
 } SEAM(pb + 1);
        } else if constexpr (l == 2) {
            Omix = (const bf16*)(ws + WS_C_O); Wo = (const bf16*)(ws + WS_C_WO);
            if (IN(pb + 0)) {
                pg8::Gemm g{XN, (const bf16*)(ws + WS_C_WD), NTOK, 1024, DM}; pg8::StaticOrder S; S.init(NTOK, 1024, G, bid);
                pg8::EpiF32 E{(float*)(ws + WS_C_QD), 1024};
                pg8::gemm_phase<pg8::EpiF32, pg8::StaticOrder, PG8_ALIGN, PG8_SP2>(lds + RING_OFF, g, S, E); if constexpr (PROBE_G == 2) { asm volatile("" ::: "memory"); pg8::gemm_phase<pg8::EpiF32, pg8::StaticOrder, PG8_ALIGN, PG8_SP2>(lds + RING_OFF, g, S, E); }
            } SEAM(pb + 0);
            if (IN(pb + 1)) { mla_thin_phase(args, wave, lane); } SEAM(pb + 1);
            if (IN(pb + 2)) {
                { int kq_ = 512; asm volatile("" : "+s"(kq_)); pg8::Gemm g{(const bf16*)(ws + WS_C_QDN), (const bf16*)(ws + WS_C_WUQ), NTOK, 3072, kq_}; pg8::StaticOrder S; S.init(NTOK, 3072, G, bid);
                  pg8::EpiMlaQ E{(bf16*)(ws + WS_C_Q), ROPE, 0.07216878364870322f * LOG2E};
                  pg8::gemm_phase<pg8::EpiMlaQ, pg8::StaticOrder, PG8_ALIGN, PG8_SP2>(lds + RING_OFF, g, S, E); if constexpr (PROBE_G == 2) { asm volatile("" ::: "memory"); pg8::gemm_phase<pg8::EpiMlaQ, pg8::StaticOrder, PG8_ALIGN, PG8_SP2>(lds + RING_OFF, g, S, E); } }
                { int kk_ = 256; asm volatile("" : "+s"(kk_)); pg8::Gemm g{(const bf16*)(ws + WS_C_CKVALL), (const bf16*)(ws + WS_C_WUKV), NKEY, 4096, kk_}; pg8::StaticOrder S; S.init(NKEY, 4096, G, bid);
                  pg8::EpiBf16<0> E{(bf16*)(ws + WS_C_KN), DM, 2048, (size_t)(WS_C_VV - WS_C_KN) / 2};
                  pg8::gemm_phase<pg8::EpiBf16<0>, pg8::StaticOrder, PG8_ALIGN, PG8_SP2>(lds + RING_OFF, g, S, E); if constexpr (PROBE_G == 2) { asm volatile("" ::: "memory"); pg8::gemm_phase<pg8::EpiBf16<0>, pg8::StaticOrder, PG8_ALIGN, PG8_SP2>(lds + RING_OFF, g, S, E); } }
            } SEAM(pb + 2);
            if (IN(pb + 3)) {
#ifndef NO_ATTN_C
 attn_phase_C(args, lds, tid, wave, lane); if constexpr (PROBE_MC == 2) { asm volatile("" ::: "memory"); attn_phase_C(args, lds, tid, wave, lane); }
#endif
 } SEAM(pb + 3);
        } else {
            Omix = (const bf16*)(ws + WS_D_O); Wo = (const bf16*)(ws + WS_D_WO);
            if (IN(pb + 0)) {
                pg8::Gemm g{XN, (const bf16*)(ws + WS_D_WQKV), NTOK, 2560, DM}; pg8::StaticOrder S; S.init(NTOK, 2560, G, bid);
                pg8::EpiQKV E{(bf16*)(ws + WS_D_Q), (bf16*)(ws + WS_D_KALL), (bf16*)(ws + WS_D_VALL), args.out + OUT_DK, args.out + OUT_DV, ROPE, 8, 1, DM, 256, 0.125f * LOG2E};
                pg8::gemm_phase<pg8::EpiQKV, pg8::StaticOrder, PG8_ALIGN, PG8_SP2>(lds + RING_OFF, g, S, E); if constexpr (PROBE_G == 2) { asm volatile("" ::: "memory"); pg8::gemm_phase<pg8::EpiQKV, pg8::StaticOrder, PG8_ALIGN, PG8_SP2>(lds + RING_OFF, g, S, E); }
            } SEAM(pb + 0);
            if (IN(pb + 1)) {
#ifndef NO_ATTN_D
 attn_phase_D(args, lds, tid, wave, lane); if constexpr (PROBE_MD == 2) { asm volatile("" ::: "memory"); attn_phase_D(args, lds, tid, wave, lane); }
#endif
 } SEAM(pb + 1);
        }
        if (IN(pb + 4)) {
            pg8::Gemm g{Omix, Wo, NTOK, DM, DM}; pg8::StaticOrder S; S.init(NTOK, DM, G, bid);
            pg8::EpiF32 E{Y, DM};
            pg8::gemm_phase<pg8::EpiF32, pg8::StaticOrder, PG8_ALIGN, PG8_SP2>(lds + RING_OFF, g, S, E); if constexpr (PROBE_G == 2) { asm volatile("" ::: "memory"); pg8::gemm_phase<pg8::EpiF32, pg8::StaticOrder, PG8_ALIGN, PG8_SP2>(lds + RING_OFF, g, S, E); }
        } SEAM(pb + 4);
        if (IN(pb + 5)) {
            const float* xp = l == 0 ? args.in[I_XP] : xout; const float* xs = l == 0 ? args.in[I_XS] : xout + (size_t)NCTX * DM;
            nr_phase<true, true>(xp, xs, xout, Y, MODl + 2 * DM, args.in[I_NMPOST] + l * DM, args.in[I_NFPRE] + l * DM, MODl + 3 * DM, MODl + 4 * DM, XN, wave, lane);
        } SEAM(pb + 5);
        if (IN(pb + 6)) {
            pg8::Gemm g{XN, (const bf16*)(ws + WS_F_WGU + (size_t)l * F_WGU_BYTES), NTOK, 2 * DFF, DM}; pg8::StaticOrder S; S.init(NTOK, 2 * DFF, G, bid);
            pg8::EpiSwiGLU E{Hb, DFF};
            pg8::gemm_phase<pg8::EpiSwiGLU, pg8::StaticOrder, PG8_ALIGN, PG8_SP2>(lds + RING_OFF, g, S, E); if constexpr (PROBE_FU == 2) { asm volatile("" ::: "memory"); pg8::gemm_phase<pg8::EpiSwiGLU, pg8::StaticOrder, PG8_ALIGN, PG8_SP2>(lds + RING_OFF, g, S, E); }
        } SEAM(pb + 6);
        if (IN(pb + 7)) {
            pg8::Gemm g{Hb, (const bf16*)(ws + WS_F_WD + (size_t)l * F_WD_BYTES), NTOK, DM, DFF}; pg8::StaticOrder S; S.init(NTOK, DM, G, bid);
            pg8::EpiF32 E{Y, DM};
            pg8::gemm_phase<pg8::EpiF32, pg8::StaticOrder, PG8_ALIGN, PG8_SP2>(lds + RING_OFF, g, S, E); if constexpr (PROBE_G == 2) { asm volatile("" ::: "memory"); pg8::gemm_phase<pg8::EpiF32, pg8::StaticOrder, PG8_ALIGN, PG8_SP2>(lds + RING_OFF, g, S, E); }
        } SEAM(pb + 7);
        if (IN(pb + 8)) {
            const float* xs2 = xout + (size_t)NCTX * DM;
            if constexpr (l < 3) nr_phase<true, true>(xout, xs2, xout, Y, MODl + 5 * DM, args.in[I_NFPOST] + l * DM, args.in[I_NMPRE] + (l + 1) * DM, MODl + 5 * MODW + 0 * DM, MODl + 5 * MODW + 1 * DM, XN, wave, lane);
            else nr_phase<true, false>(xout, xs2, xout, Y, MODl + 5 * DM, args.in[I_NFPOST] + l * DM, nullptr, nullptr, nullptr, XN, wave, lane);
        }
        if constexpr (l < 3) SEAM(pb + 8);
    }

}
__global__ void __launch_bounds__(NTHR, 2) fwd(Args args) {
    extern __shared__ __attribute__((aligned(16))) unsigned char lds_raw[];
    LAS unsigned char* lds = (LAS unsigned char*)lds_raw;
    const int tid = threadIdx.x, lane = tid & 63, wave = __builtin_amdgcn_readfirstlane(tid >> 6);
    unsigned char* ws = args.ws;
    for (int u = tid; u < (LDS_BYTES - LDSCTL_OFF) / 4; u += NTHR) ((LAS unsigned*)(lds + LDSCTL_OFF))[u] = 0u;
    __syncthreads();
#if MK_ONE_LAUNCH
    XcdBarrier bar = xcd_barrier_post((unsigned*)(ws + WS_CTL) + CW_BAR, (volatile LAS unsigned*)(lds + MISC_OFF) + 8);
#else
    XcdBarrier bar; bar.bar = nullptr; bar.x = 0; bar.st = nullptr;
#endif
    const int lo = args.ph_lo, hi = args.ph_hi;
    const float* MOD = (const float*)(ws + WS_MOD);
    const float* ROPE = (const float*)(ws + WS_ROPE);
    float* xout = args.out + OUT_Y;
    bf16* XN = (bf16*)(ws + WS_XN);
    float* Y = (float*)(ws + WS_Y);
    bf16* Hb = (bf16*)(ws + WS_H);
    const int G = gridDim.x, bid = (int)blockIdx.x;

    if (IN(0)) { p0_prologue(args, lds, tid, wave, lane); if constexpr (PROBE_P == 2) { asm volatile("" ::: "memory"); p0_prologue(args, lds, tid, wave, lane); } } SEAM(0);
    if (IN(1)) { nr_phase<false, true>(args.in[I_XP], args.in[I_XS], nullptr, nullptr, nullptr, nullptr, args.in[I_NMPRE], MOD + 0 * DM, MOD + 1 * DM, XN, wave, lane); } SEAM(1);

    Ctx cx{lds, ws, MOD, ROPE, xout, XN, Y, Hb, G, bid, lo, hi};
    layer_body<0>(args, cx, bar); layer_body<1>(args, cx, bar); layer_body<2>(args, cx, bar); layer_body<3>(args, cx, bar);
#undef IN
#undef SEAM
}

extern "C" void kernel_launch(void* const* d_in, const int* in_sizes, int n_in, void* d_out, int out_size, void* d_ws, size_t ws_size, hipStream_t stream) {
    static int grid = 0;
    if (grid == 0) {
        if (n_in != N_IN || out_size != (int)OUT_END || ws_size < WS_END) { fprintf(stderr, "kernel_launch: unexpected shapes: n_in %d out %d ws %zu (need %zu)\n", n_in, out_size, ws_size, (size_t)WS_END); grid = -1; return; }
        int dev = 0, cus = 0, per_cu = 0;
        if (hipGetDevice(&dev) != hipSuccess || hipDeviceGetAttribute(&cus, hipDeviceAttributeMultiprocessorCount, dev) != hipSuccess) { grid = -1; return; }
        if (hipFuncSetAttribute((const void*)fwd, hipFuncAttributeMaxDynamicSharedMemorySize, LDS_BYTES) != hipSuccess) { fprintf(stderr, "kernel_launch: hipFuncSetAttribute failed\n"); grid = -1; return; }
        if (hipOccupancyMaxActiveBlocksPerMultiprocessor(&per_cu, (const void*)fwd, NTHR, LDS_BYTES) != hipSuccess || per_cu < 1) fprintf(stderr, "kernel_launch: occupancy query says %d\n", per_cu);
        (void)hipGetLastError();
        grid = cus;
    }
    if (grid < 0) return;
    (void)hipMemsetAsync((char*)d_ws + WS_CTL, 0, CTL_ZERO_BYTES, stream);
    Args a{};
    for (int i = 0; i < N_IN; ++i) a.in[i] = (const float*)d_in[i];
    a.out = (float*)d_out; a.ws = (unsigned char*)d_ws;
#if MK_ONE_LAUNCH
    a.ph_lo = 0; a.ph_hi = N_PHASES;
    hipLaunchKernelGGL(fwd, dim3(grid), dim3(NTHR), LDS_BYTES, stream, a);
#else
    for (int p = 0; p < N_PHASES; ++p) { if (!phase_used(p)) continue; a.ph_lo = p; a.ph_hi = p + 1; hipLaunchKernelGGL(fwd, dim3(grid), dim3(NTHR), LDS_BYTES, stream, a); }
#endif
}
```
